# Optimizing an MI355X kernel written in HIP

```python
import jax
import jax.numpy as jnp
from jax import lax
import numpy as np

D_MODEL = 2048
BATCH = 8
SEQ = 4096
DEPTH = 4

D_MIX = D_MODEL
RWKV_HEAD_DIM = 64
RWKV_WIDTH = D_MIX // 2
RWKV_HEADS = RWKV_WIDTH // RWKV_HEAD_DIM
DECAY_RANK = 64
AAA_RANK = 64
GATE_RANK = 128
RWKV_SHIFT_WIDTH = 3 * RWKV_WIDTH + DECAY_RANK + AAA_RANK + GATE_RANK
RWKV_GN_EPS = 64e-5
CONV_WIDTH = D_MIX // 4
CONV_K = 3
HGRN_HEAD_DIM = 128
HGRN_WIDTH = D_MIX - RWKV_WIDTH - CONV_WIDTH
HGRN_HEADS = HGRN_WIDTH // HGRN_HEAD_DIM
HGRN_CHUNK = 64
HGRN_NORM_EPS = 1e-5
HGRN_MIN_FORGET = 1e-30
PROJ_WIDTH = RWKV_SHIFT_WIDTH + 3 * CONV_WIDTH + 4 * HGRN_WIDTH
D_FF = ((8 * D_MODEL // 3 + 127) // 128) * 128
FFN_RESIDUAL_SCALE = 0.5
RMS_EPS = 1e-6

kernel_name = 'hybrid_rwkv7_shortconv_hgrn2_macaron'


def _split(t, sizes):
    offs, acc = [], 0
    for s in sizes[:-1]:
        acc += s
        offs.append(acc)
    return jnp.split(t, offs, axis=-1)


def rms_norm(x, w):
    xf = x.astype(jnp.float32)
    y = xf * lax.rsqrt(jnp.mean(xf * xf, axis=-1, keepdims=True) + RMS_EPS)
    return (y * w.astype(jnp.float32)).astype(x.dtype)


def swiglu(x, w_gu, w_down):
    gate, up = jnp.split(x @ w_gu, 2, axis=-1)
    return (jax.nn.silu(gate) * up) @ w_down


def _shift_prev(t):
    return jnp.pad(t, ((0, 0), (1, 0), (0, 0)))[:, :-1]


def rwkv7_time_mix(feat, mu, w_up, w0, a_up, a0, g_up, k_k, k_a, r_k, ln_w, ln_b):
    B_, T, _ = feat.shape
    H, N = RWKV_HEADS, RWKV_HEAD_DIM
    f32 = jnp.float32
    feat = feat.astype(f32)
    feat = feat + (_shift_prev(feat) - feat) * mu.astype(f32)
    r, k, v, wd, ad, gd = _split(feat, (RWKV_WIDTH, RWKV_WIDTH, RWKV_WIDTH, DECAY_RANK, AAA_RANK, GATE_RANK))
    w = -jax.nn.softplus(-(w0.astype(f32) + jnp.tanh(wd) @ w_up.astype(f32))) - 0.5
    decay = jnp.exp(-jnp.exp(w))
    a = jax.nn.sigmoid(a0.astype(f32) + ad @ a_up.astype(f32))
    g = jax.nn.sigmoid(gd) @ g_up.astype(f32)
    heads = lambda t: t.reshape(B_, T, H, N)
    kk = heads(k * k_k.astype(f32))
    kk = kk / jnp.maximum(jnp.sqrt(jnp.sum(kk * kk, axis=-1, keepdims=True)), 1e-12)
    k = k * (1.0 + (a - 1.0) * k_a.astype(f32))
    r, k, v, decay, a = heads(r), heads(k), heads(v), heads(decay), heads(a)

    def step(S, inp):
        r_t, w_t, k_t, v_t, av_t, bv_t = inp
        sa = jnp.einsum('bhvk,bhk->bhv', S, av_t)
        S = S * w_t[:, :, None, :] + sa[..., None] * bv_t[:, :, None, :] + v_t[..., None] * k_t[:, :, None, :]
        return S, jnp.einsum('bhvk,bhk->bhv', S, r_t)

    S0 = jnp.zeros((B_, H, N, N), f32)
    xs = tuple(jnp.swapaxes(t, 0, 1) for t in (r, decay, k, v, -kk, kk * a))
    _, o = lax.scan(step, S0, xs)
    o = jnp.swapaxes(o, 0, 1)
    mean = jnp.mean(o, axis=-1, keepdims=True)
    var = jnp.mean(jnp.square(o - mean), axis=-1, keepdims=True)
    o = ((o - mean) * lax.rsqrt(var + RWKV_GN_EPS)).reshape(B_, T, RWKV_WIDTH) * ln_w.astype(f32) + ln_b.astype(f32)
    bonus = jnp.sum(r * k * r_k.astype(f32), axis=-1, keepdims=True) * v
    return (o + bonus.reshape(B_, T, RWKV_WIDTH)) * g


def short_conv_mix(c_gate, xin, b_gate, conv_w):
    T = xin.shape[1]
    z = c_gate * xin
    zp = jnp.pad(z, ((0, 0), (CONV_K - 1, 0), (0, 0)))
    y = zp[:, :T] * conv_w[0]
    for j in range(1, CONV_K):
        y = y + zp[:, j:j + T] * conv_w[j]
    return (b_gate * y).astype(jnp.float32)


def hgrn2_mix(q, f, i, og, lower_bound, norm_w):
    B_, T, _ = q.shape
    H, K, L = HGRN_HEADS, HGRN_HEAD_DIM, HGRN_CHUNK
    f32 = jnp.float32
    q = jax.nn.silu(q.astype(f32))
    f = f.astype(f32)
    lb = lower_bound.astype(f32)
    forget = lb + (1.0 - lb) * jax.nn.sigmoid(f)
    log_f = jnp.log(jnp.maximum(forget, HGRN_MIN_FORGET))
    k = (1.0 - lb) * jax.nn.sigmoid(-f)

    def chunks(t):
        return t.reshape(B_, T // L, L, H, K).transpose(1, 0, 3, 2, 4)

    causal = jnp.tril(jnp.ones((L, L), dtype=bool))[:, :, None]

    def chunk_step(S, inp):
        q_c, k_c, i_c, g_c = inp
        G = jnp.cumsum(g_c, axis=2)
        o_inter = jnp.einsum('bhtk,bhkv->bhtv', q_c * jnp.exp(G), S)
        diff = G[:, :, :, None, :] - G[:, :, None, :, :]
        rel = jnp.where(causal, jnp.exp(jnp.where(causal, diff, 0.0)), 0.0)
        scores = jnp.einsum('bhtk,bhsk,bhtsk->bhts', q_c, k_c, rel)
        o_intra = jnp.einsum('bhts,bhsv->bhtv', scores, i_c)
        G_end = G[:, :, -1:, :]
        S = jnp.exp(G_end[:, :, 0, :, None]) * S + jnp.einsum('bhsk,bhsv->bhkv', k_c * jnp.exp(G_end - G), i_c)
        return S, o_inter + o_intra

    S0 = jnp.zeros((B_, H, K, K), f32)
    _, o = lax.scan(chunk_step, S0, (chunks(q), chunks(k), chunks(i.astype(f32)), chunks(log_f)))
    o = o.transpose(1, 0, 3, 2, 4).reshape(B_, T, H, K)
    o = o * lax.rsqrt(jnp.mean(o * o, axis=-1, keepdims=True) + HGRN_NORM_EPS) * norm_w.astype(f32).reshape(H, K)
    return o.reshape(B_, T, HGRN_WIDTH) * jax.nn.silu(og.astype(f32))


def setup_inputs(seed: int = 0) -> dict:
    key = jax.random.key(seed)
    ks = jax.random.split(key, 32)
    f32 = jnp.float32
    Ld, D = DEPTH, D_MODEL

    def nrm(k, shape, scale):
        return jax.random.normal(k, shape, f32) * scale

    def gain(k, shape):
        return 1.0 + 0.02 * jax.random.normal(k, shape, f32)

    return {
        'x': nrm(ks[0], (BATCH, SEQ, D), 1.0),
        'ffn1_norm': gain(ks[1], (Ld, D)),
        'ffn1_w_gu': nrm(ks[2], (Ld, D, 2 * D_FF), D ** -0.5),
        'ffn1_w_down': nrm(ks[3], (Ld, D_FF, D), D_FF ** -0.5),
        'mix_norm': gain(ks[4], (Ld, D)),
        'w_in': nrm(ks[5], (Ld, D, PROJ_WIDTH), D ** -0.5),
        'rwkv_mu': jax.random.uniform(ks[6], (Ld, RWKV_SHIFT_WIDTH), f32, 0.0, 1.0),
        'rwkv_w_up': nrm(ks[7], (Ld, DECAY_RANK, RWKV_WIDTH), 0.5 * DECAY_RANK ** -0.5),
        'rwkv_w0': jax.random.uniform(ks[8], (Ld, RWKV_WIDTH), f32, -6.0, 0.0),
        'rwkv_a_up': nrm(ks[9], (Ld, AAA_RANK, RWKV_WIDTH), 0.5 * AAA_RANK ** -0.5),
        'rwkv_a0': nrm(ks[10], (Ld, RWKV_WIDTH), 0.1),
        'rwkv_g_up': nrm(ks[11], (Ld, GATE_RANK, RWKV_WIDTH), GATE_RANK ** -0.5),
        'rwkv_k_k': 0.85 + 0.05 * jax.random.normal(ks[12], (Ld, RWKV_WIDTH), f32),
        'rwkv_k_a': gain(ks[13], (Ld, RWKV_WIDTH)),
        'rwkv_r_k': nrm(ks[14], (Ld, RWKV_HEADS, RWKV_HEAD_DIM), 0.1),
        'rwkv_ln_w': gain(ks[15], (Ld, RWKV_WIDTH)),
        'rwkv_ln_b': nrm(ks[16], (Ld, RWKV_WIDTH), 0.02),
        'conv_w': nrm(ks[17], (Ld, CONV_K, CONV_WIDTH), CONV_K ** -0.5),
        'hgrn_lb': nrm(ks[18], (Ld, HGRN_WIDTH), 0.5),
        'hgrn_norm': gain(ks[19], (Ld, HGRN_WIDTH)),
        'w_out': nrm(ks[20], (Ld, D_MIX, D), D_MIX ** -0.5),
        'ffn2_norm': gain(ks[21], (Ld, D)),
        'ffn2_w_gu': nrm(ks[22], (Ld, D, 2 * D_FF), D ** -0.5),
        'ffn2_w_down': nrm(ks[23], (Ld, D_FF, D), D_FF ** -0.5),
        'final_norm': gain(ks[24], (D,)),
    }


def reference(x, ffn1_norm, ffn1_w_gu, ffn1_w_down, mix_norm, w_in, rwkv_mu, rwkv_w_up, rwkv_w0,
              rwkv_a_up, rwkv_a0, rwkv_g_up, rwkv_k_k, rwkv_k_a, rwkv_r_k, rwkv_ln_w, rwkv_ln_b,
              conv_w, hgrn_lb, hgrn_norm, w_out, ffn2_norm, ffn2_w_gu, ffn2_w_down, final_norm):
    p = jax.nn.softmax(hgrn_lb.astype(jnp.float32), axis=0)
    lower_bounds = jnp.cumsum(p, axis=0) - p[0]
    h = x
    for l in range(DEPTH):
        h = h + FFN_RESIDUAL_SCALE * swiglu(rms_norm(h, ffn1_norm[l]), ffn1_w_gu[l], ffn1_w_down[l])
        proj = rms_norm(h, mix_norm[l]) @ w_in[l]
        p_rwkv, p_conv, p_hgrn = _split(proj, (RWKV_SHIFT_WIDTH, 3 * CONV_WIDTH, 4 * HGRN_WIDTH))
        y_rwkv = rwkv7_time_mix(p_rwkv, rwkv_mu[l], rwkv_w_up[l], rwkv_w0[l], rwkv_a_up[l], rwkv_a0[l],
                                rwkv_g_up[l], rwkv_k_k[l], rwkv_k_a[l], rwkv_r_k[l], rwkv_ln_w[l], rwkv_ln_b[l])
        c_gate, xin, b_gate = jnp.split(p_conv, 3, axis=-1)
        y_conv = short_conv_mix(c_gate, xin, b_gate, conv_w[l])
        q, f, i, og = jnp.split(p_hgrn, 4, axis=-1)
        y_hgrn = hgrn2_mix(q, f, i, og, lower_bounds[l], hgrn_norm[l])
        y = jnp.concatenate([y_rwkv, y_conv, y_hgrn], axis=-1).astype(h.dtype)
        h = h + y @ w_out[l]
        h = h + FFN_RESIDUAL_SCALE * swiglu(rms_norm(h, ffn2_norm[l]), ffn2_w_gu[l], ffn2_w_down[l])
    return rms_norm(h, final_norm)
```

```cpp
#include <hip/hip_runtime.h>
#include <cstdio>
#include <cstdint>
#ifndef MK_N_LAUNCHES
#define MK_N_LAUNCHES 1
#endif
namespace pg8 {
#define PG8_LAS __attribute__((address_space(3)))
typedef unsigned short bf16_t;
typedef short bf16x8 __attribute__((ext_vector_type(8)));
typedef float f32x4 __attribute__((ext_vector_type(4)));
typedef unsigned u32x4 __attribute__((ext_vector_type(4)));
constexpr int BM = 256, BK = 64, HALF = 128, HTB = HALF * BK * 2  , STAGE_BYTES = 8 * HTB, NXCD = 8, WGM = 4;

__host__ __device__ __forceinline__ int lds_byte(int r, int c) { const int st = (r >> 4) * 2 + (c >> 5), rr = r & 15, cc = c & 31, ob = rr * 64 + cc * 2; return st * 1024 + (ob ^ (((ob >> 9) & 1) << 5)); }
__host__ __device__ __forceinline__ void stage_rc(int b, int& R, int& C) { const int st = b / 1024, sb = b % 1024, swz = sb ^ (((sb >> 9) & 1) << 5); R = (st >> 1) * 16 + swz / 64; C = (st & 1) * 32 + (swz % 64) / 2; }
__host__ __device__ __forceinline__ int perm32(int rho) { const int n = rho >> 4, i = rho & 15; return 8 * (i >> 2) + 4 * n + (i & 3); }

__device__ __forceinline__ int lane_id() { int x; asm volatile("v_mbcnt_lo_u32_b32 %0, -1, 0\n\tv_mbcnt_hi_u32_b32 %0, -1, %0" : "=v"(x)); return x; }

struct Unit { int pm, pn, hm; };
struct Gemm { const bf16_t* A; const bf16_t* Bt; int M, N, K; };

struct StaticOrder {
    static constexpr bool HALF_UNITS = false;
    int nM, nN, nwg, G, c;
    __host__ __device__ void init(int M, int N, int G_, int c_) { nM = M / BM; nN = N / BM; nwg = nM * nN; G = G_; c = c_; }
    __host__ __device__ void map(int L, Unit& u) const {
        int wgid = L; { const int q = nwg / NXCD, r = nwg % NXCD, xcd = wgid % NXCD, off = wgid / NXCD; wgid = (xcd < r ? xcd * (q + 1) : r * (q + 1) + (xcd - r) * q) + off; }
        const int nig = WGM * nN, gid = wgid / nig, fm = gid * WGM, gsz = (nM - fm) < WGM ? (nM - fm) : WGM;
        u.pm = fm + ((wgid % nig) % gsz); u.pn = (wgid % nig) / gsz; u.hm = 0;
    }
    __host__ __device__ bool next(int i, Unit& u) const {
        const long L = (long)i * G + c; if (L >= nwg) return false;
        map((int)L, u); return true;
    }
    __device__ __forceinline__ void a_ready(const Unit&) const {}
    __device__ __forceinline__ void done(const Unit&) const {}
};
struct PanelOrder {
    static constexpr bool HALF_UNITS = false;
    int j0, nj, G, c;
    __host__ __device__ bool next(int i, Unit& u) const {
        const long L = (long)i * G + c; if (L >= 64L * nj) return false;
        const int idx = (int)L, q = idx >> 3; u.pn = idx & 7; u.pm = 16 * (q / nj) + j0 + (q % nj); u.hm = 0; return true;
    }
    __device__ __forceinline__ void a_ready(const Unit&) const {}
    __device__ __forceinline__ void done(const Unit&) const {}
};
struct RowTileOrder {
    static constexpr bool HALF_UNITS = false;
    int pm, pn0, n;
    __device__ __forceinline__ bool next(int i, Unit& u) const { if (i >= n) return false; int p = pm; asm volatile("" : "+s"(p)); u.pm = p; u.pn = pn0 + i; u.hm = 0; return true; }
    __device__ __forceinline__ void a_ready(const Unit&) const {}
    __device__ __forceinline__ void done(const Unit&) const {}
};
struct TailSplitOrder : StaticOrder {
    static constexpr bool HALF_UNITS = true;
    __host__ __device__ bool next(int i, Unit& u) const {
        const int nfull = (nwg / G) * G, nhalf = 2 * (nwg - nfull);
        if (nhalf == G && (c & 1)) {
            if (i == 0) { map(nfull + (c >> 1), u); u.hm = 1 + (c & 1); return true; }
            const long L = (long)(i - 1) * G + c; if (L >= nfull) return false;
            map((int)L, u); return true;
        }
        const long L = (long)i * G + c;
        if (L < nfull) { map((int)L, u); return true; }
        const long hidx = L - nfull; if (hidx >= nhalf) return false;
        map(nfull + (int)(hidx >> 1), u); u.hm = 1 + (int)(hidx & 1); return true;
    }
};

typedef __bf16 bf16x2_t __attribute__((ext_vector_type(2)));
typedef float f32x2_t __attribute__((ext_vector_type(2)));
__device__ __forceinline__ unsigned cvt_pk_bf16(float lo, float hi) { const f32x2_t v = {lo, hi}; return __builtin_bit_cast(unsigned, __builtin_convertvector(v, bf16x2_t)); }
constexpr float RMS_EPS_F = 1e-6f;
typedef unsigned long long ssq_t;
constexpr float SSQ_SCALE = 16777216.0f;
__device__ __forceinline__ ssq_t ssq_fix(float s) { return (ssq_t)(s * SSQ_SCALE); }
__device__ __forceinline__ float rstd_of(const ssq_t* ss, int row) {
    const ssq_t q = __hip_atomic_load(ss + row, __ATOMIC_RELAXED, __HIP_MEMORY_SCOPE_AGENT);
    return __builtin_amdgcn_rsqf((float)q * (1.0f / (SSQ_SCALE * 2048.0f)) + RMS_EPS_F);
}

__device__ __forceinline__ void rstd8(const ssq_t* ss, int row0, int nai, float (&rs)[2][4]) {
    ssq_t q[2][4];
#pragma unroll
    for (int ai = 0; ai < 2; ++ai)
#pragma unroll
        for (int m = 0; m < 4; ++m) q[ai][m] = (ai < nai) ? __hip_atomic_load(ss + row0 + ai * HALF + m * 16, __ATOMIC_RELAXED, __HIP_MEMORY_SCOPE_AGENT) : (ssq_t)0;
#pragma unroll
    for (int ai = 0; ai < 2; ++ai)
#pragma unroll
        for (int m = 0; m < 4; ++m) rs[ai][m] = __builtin_amdgcn_rsqf((float)q[ai][m] * (1.0f / (SSQ_SCALE * 2048.0f)) + RMS_EPS_F);
}

struct RstdCache {
    const ssq_t* ss; PG8_LAS float* slot; mutable int key;
    __device__ __forceinline__ void get(const Unit& u, int wr, int fr, int fq, int nai, float (&rs)[2][4]) const {
        const int k = u.pm * 4 + u.hm;
        if (k != key) {
            key = k;
            const int lane = fq * 16 + fr, rbase = u.pm * BM + (u.hm == 2 ? HALF : 0) + wr * 64;
            ssq_t q[2];
#pragma unroll
            for (int e = 0; e < 2; ++e) { const int idx = lane + 64 * e, f = idx >> 3, ai = (idx >> 2) & 1, m = idx & 3;
                q[e] = (ai < nai) ? __hip_atomic_load(ss + rbase + ai * HALF + m * 16 + f, __ATOMIC_RELAXED, __HIP_MEMORY_SCOPE_AGENT) : (ssq_t)0; }
#pragma unroll
            for (int e = 0; e < 2; ++e) slot[lane + 64 * e] = __builtin_amdgcn_rsqf((float)q[e] * (1.0f / (SSQ_SCALE * 2048.0f)) + RMS_EPS_F);
            asm volatile("" ::: "memory");
        }
        const f32x4 a = *(const PG8_LAS f32x4*)(slot + fr * 8), b = *(const PG8_LAS f32x4*)(slot + fr * 8 + 4);
        rs[0][0] = a[0]; rs[0][1] = a[1]; rs[0][2] = a[2]; rs[0][3] = a[3]; rs[1][0] = b[0]; rs[1][1] = b[1]; rs[1][2] = b[2]; rs[1][3] = b[3];
    }
};

struct EpiSwiGLU {
    static constexpr bool PERM = true, AFTER_DRAIN = false;
    static constexpr int NVM_FULL = 8, NVM_HALF = 4;
    bf16_t* O; int ldc; RstdCache rc;
    __device__ __forceinline__ void operator()(const f32x4 (&acc)[2][2][4][2], const Unit& u, int wr, int wc, int fr_, int fq_) const {
        (void)fr_; (void)fq_;
        int lane_ = lane_id(); asm volatile("" : "+v"(lane_)); const int fr = lane_ & 15, fq = lane_ >> 4;
        const int nai = (u.hm == 0) ? 2 : 1;
        const int row0 = u.pm * BM + (u.hm == 2 ? HALF : 0) + wr * 64 + fr, col0 = u.pn * HALF + wc * 32 + 8 * fq;
        float rsv[2][4]; rc.get(u, wr, fr, fq, nai, rsv);
#pragma unroll
        for (int ai = 0; ai < 2; ++ai)
#pragma unroll
            for (int m = 0; m < 4; ++m) if (ai < nai) {
                const int row = row0 + ai * HALF + m * 16;
                const float rs = rsv[ai][m], rsl = rs * -1.4426950408889634f, rs2 = rs * rs;
                float a[8];
#pragma unroll
                for (int n = 0; n < 2; ++n)
#pragma unroll
                    for (int j = 0; j < 4; j += 2) {
                        const f32x2_t ag = {acc[ai][0][m][n][j], acc[ai][0][m][n][j + 1]}, au = {acc[ai][1][m][n][j], acc[ai][1][m][n][j + 1]};
                        const f32x2_t x = ag * rsl;
                        const f32x2_t e = {__builtin_amdgcn_exp2f(x[0]), __builtin_amdgcn_exp2f(x[1])};
                        const f32x2_t d = e + 1.0f;
                        const f32x2_t r = {__builtin_amdgcn_rcpf(d[0]), __builtin_amdgcn_rcpf(d[1])};
                        const f32x2_t o = (ag * au) * (r * rs2);
                        a[n * 4 + j] = o[0]; a[n * 4 + j + 1] = o[1];
                    }
                u32x4 w; w.x = cvt_pk_bf16(a[0], a[1]); w.y = cvt_pk_bf16(a[2], a[3]); w.z = cvt_pk_bf16(a[4], a[5]); w.w = cvt_pk_bf16(a[6], a[7]);
                *(u32x4*)(O + (size_t)row * ldc + col0) = w;
            }
    }
};
struct EpiResid {
    static constexpr bool PERM = true, AFTER_DRAIN = false;
    static constexpr int NVM_FULL = 32, NVM_HALF = 32;
    bf16_t* hb; ssq_t* ss; float scale;
    __device__ __forceinline__ void operator()(const f32x4 (&acc)[2][2][4][2], const Unit& u, int wr, int wc, int fr_, int fq_) const {
        (void)fr_; (void)fq_;
        int lane_ = lane_id(); asm volatile("" : "+v"(lane_)); const int fr = lane_ & 15, fq = lane_ >> 4;
        const int row0 = u.pm * BM + wr * 64 + fr, col0 = u.pn * BM + wc * 32 + 8 * fq;
        float sall[2][4];
#pragma unroll
        for (int ai = 0; ai < 2; ++ai) {
            u32x4 b[4][2];
#pragma unroll
            for (int m = 0; m < 4; ++m)
#pragma unroll
                for (int bj = 0; bj < 2; ++bj) b[m][bj] = *(const u32x4*)(hb + (size_t)(row0 + ai * HALF + m * 16) * 2048 + col0 + bj * HALF);
#pragma unroll
            for (int m = 0; m < 4; ++m) {
                const int row = row0 + ai * HALF + m * 16;
                float s = 0.f;
#pragma unroll
                for (int bj = 0; bj < 2; ++bj) {
                    u32x4 w;
#pragma unroll
                    for (int q = 0; q < 4; ++q) {
                        const float a0 = acc[ai][bj][m][q >> 1][2 * (q & 1)], a1 = acc[ai][bj][m][q >> 1][2 * (q & 1) + 1];
                        const float v0 = __uint_as_float(b[m][bj][q] << 16) + a0 * scale, v1 = __uint_as_float(b[m][bj][q] & 0xffff0000u) + a1 * scale;
                        const unsigned pk = cvt_pk_bf16(v0, v1); w[q] = pk;
                        const float r0 = __uint_as_float(pk << 16), r1 = __uint_as_float(pk & 0xffff0000u);
                        s += r0 * r0 + r1 * r1;
                    }
                    *(u32x4*)(hb + (size_t)row * 2048 + col0 + bj * HALF) = w;
                }
                sall[ai][m] = s;
            }
        }
        float t1[2][4];
        const int px16 = (lane_ ^ 16) << 2, px32 = (lane_ ^ 32) << 2;
#pragma unroll
        for (int ai = 0; ai < 2; ++ai)
#pragma unroll
            for (int m = 0; m < 4; ++m) t1[ai][m] = __builtin_bit_cast(float, __builtin_amdgcn_ds_bpermute(px16, __builtin_bit_cast(int, sall[ai][m])));
#pragma unroll
        for (int ai = 0; ai < 2; ++ai)
#pragma unroll
            for (int m = 0; m < 4; ++m) sall[ai][m] += t1[ai][m];
#pragma unroll
        for (int ai = 0; ai < 2; ++ai)
#pragma unroll
            for (int m = 0; m < 4; ++m) t1[ai][m] = __builtin_bit_cast(float, __builtin_amdgcn_ds_bpermute(px32, __builtin_bit_cast(int, sall[ai][m])));
        if (fq == 0) {
#pragma unroll
            for (int ai = 0; ai < 2; ++ai)
#pragma unroll
                for (int m = 0; m < 4; ++m) atomicAdd(ss + row0 + ai * HALF + m * 16, ssq_fix(sall[ai][m] + t1[ai][m]));
        }
    }
};
struct EpiBf16S {
    static constexpr bool PERM = true, AFTER_DRAIN = false;
    static constexpr int NVM_FULL = 16, NVM_HALF = 8;
    bf16_t* O; int ldc; RstdCache rc;
    __device__ __forceinline__ void operator()(const f32x4 (&acc)[2][2][4][2], const Unit& u, int wr, int wc, int fr_, int fq_) const {
        (void)fr_; (void)fq_;
        int lane_ = lane_id(); asm volatile("" : "+v"(lane_)); const int fr = lane_ & 15, fq = lane_ >> 4;
        const int nai = (u.hm == 0) ? 2 : 1;
        const int row0 = u.pm * BM + (u.hm == 2 ? HALF : 0) + wr * 64 + fr, col0 = u.pn * BM + wc * 32 + 8 * fq;
        float rsv[2][4]; rc.get(u, wr, fr, fq, nai, rsv);
#pragma unroll
        for (int ai = 0; ai < 2; ++ai)
#pragma unroll
            for (int m = 0; m < 4; ++m) if (ai < nai) {
                const int row = row0 + ai * HALF + m * 16;
                const float rs = rsv[ai][m];
                bf16_t* rowp = O + (size_t)row * ldc + col0;
#pragma unroll
                for (int bj = 0; bj < 2; ++bj) {
                    const f32x4 v0 = acc[ai][bj][m][0] * rs, v1 = acc[ai][bj][m][1] * rs;
                    u32x4 w; w.x = cvt_pk_bf16(v0[0], v0[1]); w.y = cvt_pk_bf16(v0[2], v0[3]); w.z = cvt_pk_bf16(v1[0], v1[1]); w.w = cvt_pk_bf16(v1[2], v1[3]);
                    *(u32x4*)(rowp + bj * HALF) = w;
                }
            }
    }
};

template <class Epi, class Sched, bool ALIGN_EPI = false, bool SP2 = false>
__device__ __forceinline__ void gemm_phase(PG8_LAS unsigned char* lds, const Gemm g, const Sched& S, const Epi& E, const int wid  ) {
    int lane_ = lane_id(); asm volatile("" : "+v"(lane_));
    const int lane = lane_, tid = wid * 64 + lane, wr = wid >> 2, wc = wid & 3, fr = lane & 15, fq = lane >> 4;
    const int K = g.K, nt = K / BK;
    unsigned voffA[2], voffB[2];
#pragma unroll
    for (int i = 0; i < 2; ++i) { int R, C; stage_rc(tid * 16 + i * 8192, R, C); const int Rb = Epi::PERM ? ((R & ~31) + perm32(R & 31)) : R;
        voffA[i] = (unsigned)(R * K + C) * 2u; voffB[i] = (unsigned)(Rb * K + C) * 2u; }
    const unsigned kstep = (unsigned)(BK * 2);
    const unsigned hstep = (unsigned)HALF * (unsigned)K * 2u;
    const unsigned tstep = 2u * hstep;
    const __amdgpu_buffer_rsrc_t rsA = __builtin_amdgcn_make_buffer_rsrc((void*)g.A, (short)0, 0x7ffffff0, 0x00020000), rsB = __builtin_amdgcn_make_buffer_rsrc((void*)g.Bt, (short)0, 0x7ffffff0, 0x00020000);
    const unsigned ldsw = (unsigned)wid * 1024u;
    const int aoff = lds_byte(wr * 64 + fr, fq * 8), boff = lds_byte(wc * 32 + fr, fq * 8);
#define PG8_SA(b, h) (((b) * 2 + (h)) * HTB)
#define PG8_SB(b, h) ((4 + (b) * 2 + (h)) * HTB)
#define PG8_STAGE(bufoff, rs, soff, voff) do { _Pragma("unroll") for (int _i = 0; _i < 2; ++_i) \
        __builtin_amdgcn_raw_ptr_buffer_load_lds((rs), (PG8_LAS void*)(lds + (bufoff) + ldsw + _i * 8192), 16, (int)(voff)[_i], (int)(soff), 0, 0); } while (0)
#define PG8_LDA(dst, b, h) do { _Pragma("unroll") for (int m = 0; m < 4; ++m) _Pragma("unroll") for (int k = 0; k < 2; ++k) dst[m][k] = *(const PG8_LAS bf16x8*)(lds + PG8_SA(b, h) + aoff + m * 2048 + k * 1024); } while (0)
#define PG8_LDB(dst, b, h) do { _Pragma("unroll") for (int n = 0; n < 2; ++n) _Pragma("unroll") for (int k = 0; k < 2; ++k) dst[n][k] = *(const PG8_LAS bf16x8*)(lds + PG8_SB(b, h) + boff + n * 2048 + k * 1024); } while (0)
#define PG8_MMA(ai, bj, At, Bt) do { __builtin_amdgcn_s_setprio(1); _Pragma("unroll") for (int m = 0; m < 4; ++m) _Pragma("unroll") for (int n = 0; n < 2; ++n) _Pragma("unroll") for (int k = 0; k < 2; ++k) \
        acc[ai][bj][m][n] = __builtin_amdgcn_mfma_f32_16x16x32_bf16(Bt[n][k], At[m][k], acc[ai][bj][m][n], 0, 0, 0); __builtin_amdgcn_s_setprio(0); } while (0)
#define PG8_WAIT_V(n) asm volatile("s_waitcnt vmcnt(" #n ")" ::: "memory")
#define PG8_WAIT_L(n) asm volatile("s_waitcnt lgkmcnt(" #n ")" ::: "memory")
#define PG8_WAIT_VN(n) asm volatile("s_waitcnt vmcnt(%0)" :: "n"(n) : "memory")
#define PG8_BAR __builtin_amdgcn_s_barrier()
#define PG8_SCHED __builtin_amdgcn_sched_barrier(0)
#define PG8_TRIP(W1, W2) do { \
            PG8_LDB(B0, 0, 0); PG8_LDB(B1, 0, 1); PG8_SCHED; PG8_LDA(At, 0, 0); PG8_STAGE(PG8_SA(1, 1), rsA, a1 + hstep, voffA); \
            W1; PG8_WAIT_L(0); PG8_BAR; PG8_MMA(0, 0, At, B0); PG8_MMA(0, 1, At, B1); PG8_BAR; PG8_SCHED; \
            PG8_LDA(At, 0, 1); PG8_STAGE(PG8_SB(0, 0), rsB, b2, voffB); PG8_STAGE(PG8_SB(0, 1), rsB, b2 + hstep, voffB); PG8_STAGE(PG8_SA(0, 0), rsA, a2, voffA); \
            W2; PG8_WAIT_L(0); PG8_BAR; if (cur.hm == 0) { PG8_MMA(1, 0, At, B0); PG8_MMA(1, 1, At, B1); } PG8_BAR; PG8_SCHED; \
            PG8_LDB(B0, 1, 0); PG8_LDB(B1, 1, 1); PG8_SCHED; PG8_LDA(At, 1, 0); PG8_STAGE(PG8_SA(0, 1), rsA, a2 + hstep, voffA); \
            PG8_WAIT_V(8); PG8_WAIT_L(0); PG8_BAR; PG8_MMA(0, 0, At, B0); PG8_MMA(0, 1, At, B1); PG8_BAR; PG8_SCHED; \
            PG8_LDA(At, 1, 1); PG8_STAGE(PG8_SB(1, 0), rsB, b3, voffB); PG8_STAGE(PG8_SB(1, 1), rsB, b3 + hstep, voffB); PG8_STAGE(PG8_SA(1, 0), rsA, a3, voffA); \
            PG8_WAIT_V(8); PG8_WAIT_L(0); PG8_BAR; if (cur.hm == 0) { PG8_MMA(1, 0, At, B0); PG8_MMA(1, 1, At, B1); } PG8_BAR; PG8_SCHED; \
            } while (0)
    Unit cur, nxt; int ui = 0;
    if (!S.next(0, cur)) return;
    f32x4 acc[2][2][4][2];
#pragma unroll
    for (int a = 0; a < 2; ++a)
#pragma unroll
        for (int b = 0; b < 2; ++b)
#pragma unroll
            for (int m = 0; m < 4; ++m)
#pragma unroll
                for (int n = 0; n < 2; ++n) acc[a][b][m][n] = (f32x4){0.f, 0.f, 0.f, 0.f};
    bf16x8 At[4][2], B0[2][2], B1[2][2];
    unsigned cA = (unsigned)cur.pm * tstep + (cur.hm == 2 ? hstep : 0u), cB = (unsigned)cur.pn * tstep;
    S.a_ready(cur);
    if constexpr (SP2) {
        PG8_STAGE(PG8_SB(0, 0), rsB, cB, voffB); PG8_STAGE(PG8_SB(0, 1), rsB, cB + hstep, voffB); PG8_STAGE(PG8_SA(0, 0), rsA, cA, voffA); PG8_STAGE(PG8_SA(0, 1), rsA, cA + hstep, voffA);
        PG8_STAGE(PG8_SB(1, 0), rsB, cB + kstep, voffB); PG8_STAGE(PG8_SA(1, 0), rsA, cA + kstep, voffA); PG8_STAGE(PG8_SB(1, 1), rsB, cB + hstep + kstep, voffB);
        if (wr == 1) PG8_BAR;
        PG8_WAIT_V(0); PG8_BAR;
        PG8_BAR;
    } else {
        PG8_STAGE(PG8_SB(0, 0), rsB, cB, voffB); PG8_STAGE(PG8_SA(0, 0), rsA, cA, voffA); PG8_STAGE(PG8_SB(0, 1), rsB, cB + hstep, voffB); PG8_STAGE(PG8_SA(0, 1), rsA, cA + hstep, voffA);
        if (wr == 1) PG8_BAR;
        PG8_WAIT_V(4); PG8_BAR;
        PG8_STAGE(PG8_SB(1, 0), rsB, cB + kstep, voffB); PG8_STAGE(PG8_SA(1, 0), rsA, cA + kstep, voffA); PG8_STAGE(PG8_SB(1, 1), rsB, cB + hstep + kstep, voffB);
        PG8_WAIT_V(6); PG8_BAR;
    }
    for (;;) {
        const bool has_next = S.next(ui + 1, nxt);
        const unsigned nA = has_next ? (unsigned)nxt.pm * tstep + (nxt.hm == 2 ? hstep : 0u) : cA, nB = has_next ? (unsigned)nxt.pn * tstep : cB;
        int t0 = 0;
        if constexpr (SP2) {
            constexpr int NVM = Sched::HALF_UNITS ? Epi::NVM_HALF : Epi::NVM_FULL;
            const unsigned a1 = cA + kstep, a2 = cA + 2 * kstep, b2 = cB + 2 * kstep, a3 = a2 + kstep, b3 = b2 + kstep;
            PG8_TRIP(PG8_WAIT_VN(8 + NVM), PG8_WAIT_VN(8 + NVM));
            t0 = 2;
        }
        for (int t = t0; t < nt; t += 2) {
            const bool last = (t == nt - 2);
            const unsigned a1 = cA + (unsigned)(t + 1) * kstep;
            const unsigned a2 = last ? nA : cA + (unsigned)(t + 2) * kstep, b2 = last ? nB : cB + (unsigned)(t + 2) * kstep;
            const unsigned a3 = a2 + kstep, b3 = b2 + kstep;
            if (last && has_next) S.a_ready(nxt);
            if constexpr (SP2) {
            PG8_TRIP(PG8_WAIT_V(8), PG8_WAIT_V(8));
            } else {
            PG8_LDB(B0, 0, 0); PG8_SCHED; PG8_LDA(At, 0, 0); PG8_STAGE(PG8_SA(1, 1), rsA, a1 + hstep, voffA);
            PG8_WAIT_L(8); PG8_BAR; PG8_WAIT_L(0); PG8_MMA(0, 0, At, B0); PG8_BAR; PG8_SCHED;
            PG8_LDB(B1, 0, 1); PG8_STAGE(PG8_SB(0, 0), rsB, b2, voffB);
            PG8_BAR; PG8_WAIT_L(0); PG8_MMA(0, 1, At, B1); PG8_BAR;
            PG8_LDA(At, 0, 1); PG8_STAGE(PG8_SA(0, 0), rsA, a2, voffA);
            PG8_BAR; PG8_WAIT_L(0); if (cur.hm == 0) PG8_MMA(1, 0, At, B0); PG8_BAR; PG8_SCHED;
            PG8_STAGE(PG8_SB(0, 1), rsB, b2 + hstep, voffB);
            PG8_WAIT_V(6); PG8_BAR; if (cur.hm == 0) PG8_MMA(1, 1, At, B1); PG8_BAR;
            PG8_LDB(B0, 1, 0); PG8_SCHED; PG8_LDA(At, 1, 0); PG8_STAGE(PG8_SA(0, 1), rsA, a2 + hstep, voffA);
            PG8_WAIT_L(8); PG8_BAR; PG8_WAIT_L(0); PG8_MMA(0, 0, At, B0); PG8_BAR; PG8_SCHED;
            PG8_LDB(B1, 1, 1); PG8_STAGE(PG8_SB(1, 0), rsB, b3, voffB);
            PG8_BAR; PG8_WAIT_L(0); PG8_MMA(0, 1, At, B1); PG8_BAR;
            PG8_LDA(At, 1, 1); PG8_STAGE(PG8_SA(1, 0), rsA, a3, voffA);
            PG8_BAR; PG8_WAIT_L(0); if (cur.hm == 0) PG8_MMA(1, 0, At, B0); PG8_BAR; PG8_SCHED;
            PG8_STAGE(PG8_SB(1, 1), rsB, b3 + hstep, voffB);
            PG8_WAIT_V(6); PG8_BAR; if (cur.hm == 0) PG8_MMA(1, 1, At, B1); PG8_BAR;
            }
        }
        if constexpr (ALIGN_EPI) { if (wr == 0) PG8_BAR; }
        if constexpr (!Epi::AFTER_DRAIN) { E(acc, cur, wr, wc, fr, fq); S.done(cur); }
        if (!has_next) break;
#pragma unroll
        for (int a = 0; a < 2; ++a)
#pragma unroll
            for (int b = 0; b < 2; ++b)
#pragma unroll
                for (int m = 0; m < 4; ++m)
#pragma unroll
                    for (int n = 0; n < 2; ++n) acc[a][b][m][n] = (f32x4){0.f, 0.f, 0.f, 0.f};
        cur = nxt; cA = nA; cB = nB; ++ui;
        if constexpr (ALIGN_EPI) { if (wr == 1) PG8_BAR; }
    }
    PG8_WAIT_V(0);
    if constexpr (!ALIGN_EPI) { if (wr == 0) PG8_BAR; }
    PG8_BAR;
    if constexpr (Epi::AFTER_DRAIN) { E.fused(acc, cur, wr, wc, fr, fq, lds, wid, lane); S.done(cur); }
#undef PG8_SA
#undef PG8_SB
#undef PG8_STAGE
#undef PG8_LDA
#undef PG8_LDB
#undef PG8_MMA
#undef PG8_WAIT_V
#undef PG8_WAIT_L
#undef PG8_WAIT_VN
#undef PG8_TRIP
#undef PG8_BAR
#undef PG8_SCHED
}
}

constexpr int NWAVES = 8;
constexpr int D = 2048, BATCH = 8, T = 4096, M = BATCH * T, DEPTH = 4;
constexpr int RW = 1024;
constexpr int PW = 6912, FF = 5504, LRK = 256, LRN = 3072;
constexpr int P_LR = 3072;
constexpr int P_CONV = 3328, P_HG = 4864;
constexpr int Y_CONV = 1024, Y_HG = 1536;
constexpr int NPH = 2 + DEPTH * 8;

constexpr size_t MiB = 1u << 20;
constexpr size_t WS_CTL = 0, WS_SS = 1 * MiB, ZERO_BYTES = 5 * MiB;
constexpr size_t W_GU1 = 8 * MiB, W_D1 = W_GU1 + (size_t)2 * FF * D * 2, W_IN = W_D1 + (size_t)D * FF * 2, W_LR = W_IN + (size_t)PW * D * 2,
                 W_OUT = W_LR + (size_t)LRN * LRK * 2, W_GU2 = W_OUT + (size_t)D * D * 2, W_D2 = W_GU2 + (size_t)2 * FF * D * 2, W_END = W_D2 + (size_t)D * FF * 2;
static_assert(W_END <= 176 * MiB && WS_SS + (size_t)13 * M * 8 <= ZERO_BYTES, "ws map");
constexpr size_t WS_HB = 176 * MiB;
constexpr size_t WS_PROJ = 304 * MiB;
constexpr size_t WS_ACT = 304 * MiB;
constexpr size_t WS_LRA = 736 * MiB;
constexpr size_t WS_LR = 752 * MiB;
constexpr size_t WS_Y = 944 * MiB;
constexpr size_t WS_END = 1072 * MiB;
constexpr int CW_BAR = 4096;
constexpr int RING_BYTES = 131072, MISC_OFF = 146432, PTAB_OFF = MISC_OFF + 128, LDS_BYTES = 147456;

#define GAS __attribute__((address_space(1)))
#define LAS __attribute__((address_space(3)))
typedef unsigned short bf16;
typedef unsigned v4u __attribute__((ext_vector_type(4)));
typedef unsigned v2u __attribute__((ext_vector_type(2)));
typedef float f32x4 __attribute__((ext_vector_type(4)));
#define LDS_WAIT() asm volatile("s_waitcnt lgkmcnt(0)" ::: "memory")
typedef __bf16 bf16x2_t __attribute__((ext_vector_type(2)));
typedef float f32x2_t __attribute__((ext_vector_type(2)));
__device__ __forceinline__ unsigned pk2(float lo, float hi) { const f32x2_t v = {lo, hi}; return __builtin_bit_cast(unsigned, __builtin_convertvector(v, bf16x2_t)); }
__device__ __forceinline__ unsigned f2bf(float f) { return pk2(f, f) & 0xffffu; }
__device__ __forceinline__ float bf2f(bf16 x) { return __uint_as_float(((unsigned)x) << 16); }
__device__ __forceinline__ float bflo(unsigned u) { return __uint_as_float(u << 16); }
__device__ __forceinline__ float bfhi(unsigned u) { return __uint_as_float(u & 0xffff0000u); }
__device__ __forceinline__ float sigm(float x) { return __builtin_amdgcn_rcpf(1.0f + __expf(-x)); }
template <int CTRL> __device__ __forceinline__ float dpp_mov(float v) { return __builtin_bit_cast(float, __builtin_amdgcn_update_dpp(0, __builtin_bit_cast(int, v), CTRL, 0xF, 0xF, true)); }
__device__ __forceinline__ float wave_sum(float v) {
    v += dpp_mov<0xB1>(v); v += dpp_mov<0x4E>(v); v += dpp_mov<0x141>(v); v += dpp_mov<0x140>(v);
    const int iv = __builtin_bit_cast(int, v);
    const float r0 = __builtin_bit_cast(float, __builtin_amdgcn_readlane(iv, 0)), r1 = __builtin_bit_cast(float, __builtin_amdgcn_readlane(iv, 16));
    const float r2 = __builtin_bit_cast(float, __builtin_amdgcn_readlane(iv, 32)), r3 = __builtin_bit_cast(float, __builtin_amdgcn_readlane(iv, 48));
    return (r0 + r1) + (r2 + r3);
}
__device__ __forceinline__ float dpp_f(float v, const int ctrl_sel) {
    const int x = __builtin_bit_cast(int, v);
    int r;
    if (ctrl_sel == 0) r = __builtin_amdgcn_update_dpp(0, x, 0xB1, 0xF, 0xF, true);
    else if (ctrl_sel == 1) r = __builtin_amdgcn_update_dpp(0, x, 0x4E, 0xF, 0xF, true);
    else r = __builtin_amdgcn_update_dpp(0, x, 0x141, 0xF, 0xF, true);
    return __builtin_bit_cast(float, r);
}
__device__ __forceinline__ float sum8(float v) { v += dpp_f(v, 0); v += dpp_f(v, 1); v += dpp_f(v, 2); return v; }


struct PTab {
    LAS unsigned long long* t;
    __device__ __forceinline__ const float* operator[](int i) const {
        const unsigned long long v = t[i];
        const unsigned lo = __builtin_amdgcn_readfirstlane((unsigned)v), hi = __builtin_amdgcn_readfirstlane((unsigned)(v >> 32));
        return (const float*)(const GAS float*)(((unsigned long long)hi << 32) | lo);
    }
};
#define XB_TMO      128
#define XB_XCNT(j)  (256  + 64 * (j))
#define XB_XSUB(j)  (1280 + 64 * (j))
#define XB_XGEN(j)  (2304 + 64 * (j))
#define XB_TOP      3328
#define XB_TOPGEN   3392
#define XCD_BAR_WORDS 3456
#define XB_SPIN_CAP (1u << 18)

__device__ __forceinline__ unsigned xb_ld(unsigned* p)              { return __hip_atomic_load(p, __ATOMIC_RELAXED, __HIP_MEMORY_SCOPE_AGENT); }
__device__ __forceinline__ unsigned xb_add(unsigned* p, unsigned v) { return __hip_atomic_fetch_add(p, v, __ATOMIC_RELAXED, __HIP_MEMORY_SCOPE_AGENT); }
__device__ __forceinline__ unsigned xb_xcc_id() { return (unsigned)__builtin_amdgcn_s_getreg((3 << 11) | 20) & 0xFu; }
#define XB_SPIN(cond, bar) do { unsigned _sp = 0; while (cond) { __builtin_amdgcn_s_sleep(1); \
    if ((++_sp & 255u) == 0u) { if (xb_ld(&(bar)[XB_TMO])) break; if (_sp > XB_SPIN_CAP) { atomicAdd(&(bar)[XB_TMO], 1u); break; } } } } while (0)

struct XcdBarrier {
    unsigned* bar; unsigned x;
    bool lead;
    volatile LAS unsigned* st;
};

__device__ __forceinline__ XcdBarrier xcd_barrier_post(unsigned* bar, volatile LAS unsigned* st) {
    XcdBarrier b; b.bar = bar; b.x = xb_xcc_id(); b.st = st; b.lead = (threadIdx.x == 0);
    if (b.lead) (void)xb_add(&bar[XB_XCNT(b.x)], 1u);
    return b;
}
__device__ __forceinline__ void xcd_barrier_complete(unsigned* bar, unsigned x, unsigned& nloc, unsigned& nx) {
    const unsigned G = gridDim.x * gridDim.y * gridDim.z;
    unsigned sum, cnt, mine, sp = 0u;
    for (;;) {
        sum = 0u; cnt = 0u; mine = 0u;
#pragma unroll
        for (unsigned j = 0; j < 16; ++j) { const unsigned c = xb_ld(&bar[XB_XCNT(j)]); sum += c; cnt += (c > 0u) ? 1u : 0u; mine = (j == x) ? c : mine; }
        if (sum == G) break;
        __builtin_amdgcn_s_sleep(1);
        if ((++sp & 255u) == 0u) { if (xb_ld(&bar[XB_TMO])) break; if (sp > XB_SPIN_CAP) { atomicAdd(&bar[XB_TMO], 1u); break; } }
    }
    nloc = mine > 0u ? mine : 1u; nx = cnt > 0u ? cnt : 1u;
}

__device__ __forceinline__ void xcd_barrier(const XcdBarrier& b) {
    asm volatile("s_waitcnt vmcnt(0)" ::: "memory");
    __syncthreads();
    if (b.lead) {
        unsigned* bar = b.bar;
        __builtin_amdgcn_s_waitcnt(0);
        unsigned nloc = b.st[0], nx = b.st[1];
        if (nloc == 0u) { xcd_barrier_complete(bar, b.x, nloc, nx); b.st[0] = nloc; b.st[1] = nx; }
        const unsigned old = xb_add(&bar[XB_XSUB(b.x)], 1u);
        const unsigned gen = old / nloc;
        if (old + 1u == (gen + 1u) * nloc) {
            __builtin_amdgcn_fence(__ATOMIC_RELEASE, "agent");
            asm volatile("s_waitcnt vmcnt(0)" ::: "memory");
            const unsigned og = xb_add(&bar[XB_TOP], 1u);
            const unsigned tg = og / nx;
            if (og + 1u == (tg + 1u) * nx) xb_add(&bar[XB_TOPGEN], 1u);
            else XB_SPIN(xb_ld(&bar[XB_TOPGEN]) == tg, bar);
            __builtin_amdgcn_fence(__ATOMIC_ACQUIRE, "agent");
            xb_add(&bar[XB_XGEN(b.x)], 1u);
            asm volatile("s_waitcnt vmcnt(0)" ::: "memory");
        } else {
            XB_SPIN(xb_ld(&bar[XB_XGEN(b.x)]) == gen, bar);
            __builtin_amdgcn_fence(__ATOMIC_ACQUIRE, "agent");
            asm volatile("s_waitcnt vmcnt(0)" ::: "memory");
        }
    }
    __syncthreads();
}

struct GBar { unsigned* bar; volatile LAS unsigned* st; int wv; };
__device__ __forceinline__ void grid_sync(const GBar& g) { XcdBarrier b; b.bar = g.bar; b.x = xb_xcc_id(); b.st = g.st; b.lead = (g.wv == 0) && (pg8::lane_id() == 0); xcd_barrier(b); }
constexpr int SEG_C1 = 24, SEG_C2 = 44, SEG_C3 = 54;
constexpr int SEG_J1 = 6, SEG_J2 = 9, SEG_J3 = 12;
static_assert(4 * SEG_J1 <= SEG_C1 && 4 * SEG_J2 <= SEG_C2 && 4 * SEG_J3 <= SEG_C3, "a panel's chunks are done before its W_out units start");

typedef short bf16x8 __attribute__((ext_vector_type(8)));
typedef float f32x16 __attribute__((ext_vector_type(16)));
#define LBAR() do { asm volatile("s_waitcnt lgkmcnt(0)" ::: "memory"); __builtin_amdgcn_s_barrier(); asm volatile("" ::: "memory"); } while (0)
#define MFMA32(a, b, c) __builtin_amdgcn_mfma_f32_32x32x16_bf16((a), (b), (c), 0, 0, 0)
__device__ __forceinline__ bf16x8 ldfrag(const LAS unsigned char* base, int row, int ld, int kbyte) { return *(const LAS bf16x8*)(base + row * ld + kbyte); }

__device__ __forceinline__ void hgrn_chain_mfma(LAS unsigned char* lds, PTab in, int l, int b, int hh, const bf16* proj, bf16* y, int tid, GBar gb) {
    constexpr int LD128 = 272, LD64 = 144, LDO = 132;
    constexpr int O_QH = 0, O_QM = 17408, O_KM = 34816, O_KHT = 52224, O_IT = 70656, O_ST = 89088, O_SC = 123904, O_EGL = 133120, O_PQ = 133632;
    const int lane = tid & 63, wave = __builtin_amdgcn_readfirstlane(tid >> 6);
    LAS unsigned char* Qh = lds + O_QH; LAS unsigned char* Qm = lds + O_QM; LAS unsigned char* Km = lds + O_KM; LAS unsigned char* KhT = lds + O_KHT;
    LAS unsigned char* iT = lds + O_IT; LAS unsigned char* St = lds + O_ST; LAS unsigned char* Sc = lds + O_SC;
    LAS float* eGL = (LAS float*)(lds + O_EGL); LAS float* Pq = (LAS float*)(lds + O_PQ); LAS float* Ob = (LAS float*)lds;
    const int pk0 = (wave & 1) * 64 + lane, tq = wave >> 1;
    float lb;
    {
        const float* hlb = in[18]; const int cc = hh * 128 + pk0;
        const float x0 = hlb[cc], x1 = hlb[512 + cc], x2 = hlb[1024 + cc], x3 = hlb[1536 + cc];
        const float mx = fmaxf(fmaxf(x0, x1), fmaxf(x2, x3));
        const float e0 = expf(x0 - mx), e1 = expf(x1 - mx), e2 = expf(x2 - mx), e3 = expf(x3 - mx);
        float acc = 0.f; if (l >= 1) acc += e1; if (l >= 2) acc += e2; if (l >= 3) acc += e3;
        lb = acc / (e0 + e1 + e2 + e3);
    }
    const float* hn = in[19];
    const float nw0 = hn[l * 512 + hh * 128 + lane], nw1 = hn[l * 512 + hh * 128 + 64 + lane];
    const int sti = wave >> 1, ssi = wave & 1;
    const int oti = wave >> 2, ovi = wave & 3;
    const int ki = wave >> 1, vj0 = 2 * (wave & 1);
    f32x16 S0, S1;
#pragma unroll
    for (int i = 0; i < 16; ++i) { S0[i] = 0.f; S1[i] = 0.f; }
    for (int i = tid; i < 34816 / 4; i += 512) ((LAS unsigned*)St)[i] = 0u;
    const size_t mbase = (size_t)b * T;
    const bf16* pcol = proj + P_HG + hh * 128;
    bf16 rq[16], rf[16], ri[16], rg[16];
    auto load_raw = [&](int c) {
        const bf16* p = pcol + (mbase + (size_t)c * 64 + 16 * tq) * PW + pk0;
#pragma unroll
        for (int j = 0; j < 16; ++j) { rq[j] = p[(size_t)j * PW]; rf[j] = p[(size_t)j * PW + 512]; ri[j] = p[(size_t)j * PW + 1024]; }
        const bf16* pg = pcol + 1536 + (mbase + (size_t)c * 64 + 8 * wave) * PW + lane;
#pragma unroll
        for (int j = 0; j < 8; ++j) { rg[2 * j] = pg[(size_t)j * PW]; rg[2 * j + 1] = pg[(size_t)j * PW + 64]; }
    };
    load_raw(0);
    __syncthreads();
    for (int c = 0; c < T / 64; ++c) {
        if (c == SEG_C1 || c == SEG_C2 || c == SEG_C3) grid_sync(gb);
        int ln = lane; asm volatile("" : "+v"(ln));
        const int r = ln & 31, h = ln >> 5, pk = (wave & 1) * 64 + ln;
        float cq[16], ck[16], cg[16]; unsigned ipk[8]; float og[16];
        {
            float run = 0.f;
#pragma unroll
            for (int j = 0; j < 16; ++j) {
                const float f = bf2f(rf[j]), sg = sigm(f);
                run += __logf(fmaxf(lb + (1.0f - lb) * sg, 1e-30f)); cg[j] = run;
                ck[j] = (1.0f - lb) * (1.0f - sg);
                const float qr = bf2f(rq[j]); cq[j] = qr * sigm(qr);
            }
#pragma unroll
            for (int j = 0; j < 8; ++j) ipk[j] = (unsigned)ri[2 * j] | ((unsigned)ri[2 * j + 1] << 16);
#pragma unroll
            for (int j = 0; j < 16; ++j) og[j] = bf2f(rg[j]);
            Pq[tq * 128 + pk] = run;
        }
        LBAR();
        {
            const float p0 = Pq[pk], p1 = Pq[128 + pk], p2 = Pq[256 + pk], p3 = Pq[384 + pk];
            const float pre = (tq > 0 ? p0 : 0.f) + (tq > 1 ? p1 : 0.f) + (tq > 2 ? p2 : 0.f), GL = (p0 + p1) + (p2 + p3), Gmid = p0 + p1;
            unsigned kh[8];
#pragma unroll
            for (int j = 0; j < 16; j += 2) {
                float khv[2];
#pragma unroll
                for (int e = 0; e < 2; ++e) {
                    const int t = 16 * tq + j + e; const float G = pre + cg[j + e];
                    *(LAS bf16*)(Qh + t * LD128 + 2 * pk) = (bf16)f2bf(cq[j + e] * __expf(G));
                    *(LAS bf16*)(Qm + t * LD128 + 2 * pk) = (bf16)f2bf(cq[j + e] * __expf(fminf(G - Gmid, 80.f)));
                    *(LAS bf16*)(Km + t * LD128 + 2 * pk) = (bf16)f2bf(ck[j + e] * __expf(fminf(Gmid - G, 80.f)));
                    khv[e] = ck[j + e] * __expf(GL - G);
                }
                kh[j >> 1] = pk2(khv[0], khv[1]);
            }
            *(LAS v4u*)(KhT + pk * LD64 + 32 * tq) = (v4u){kh[0], kh[1], kh[2], kh[3]};
            *(LAS v4u*)(KhT + pk * LD64 + 32 * tq + 16) = (v4u){kh[4], kh[5], kh[6], kh[7]};
            *(LAS v4u*)(iT + pk * LD64 + 32 * tq) = (v4u){ipk[0], ipk[1], ipk[2], ipk[3]};
            *(LAS v4u*)(iT + pk * LD64 + 32 * tq + 16) = (v4u){ipk[4], ipk[5], ipk[6], ipk[7]};
            if (tq == 0) eGL[pk] = __expf(GL);
        }
        LBAR();
        if (c + 1 < T / 64) load_raw(c + 1);
        auto s_update = [&]() {
#pragma unroll
            for (int g = 0; g < 4; ++g) { const f32x4 e = *(const LAS f32x4*)(eGL + 32 * ki + 8 * g + 4 * h);
#pragma unroll
                for (int q = 0; q < 4; ++q) { S0[4 * g + q] *= e[q]; S1[4 * g + q] *= e[q]; } }
#pragma unroll
            for (int ks = 0; ks < 4; ++ks) {
                const bf16x8 a = ldfrag(KhT, 32 * ki + r, LD64, 32 * ks + 16 * h);
                const bf16x8 b0 = ldfrag(iT, 32 * vj0 + r, LD64, 32 * ks + 16 * h), b1 = ldfrag(iT, 32 * (vj0 + 1) + r, LD64, 32 * ks + 16 * h);
                S0 = MFMA32(a, b0, S0); S1 = MFMA32(a, b1, S1);
            }
        };
        if (wave < 4) {
            f32x16 sc;
#pragma unroll
            for (int i = 0; i < 16; ++i) sc[i] = 0.f;
#pragma unroll
            for (int ks = 0; ks < 8; ++ks) sc = MFMA32(ldfrag(Qm, 32 * sti + r, LD128, 32 * ks + 16 * h), ldfrag(Km, 32 * ssi + r, LD128, 32 * ks + 16 * h), sc);
            const int s = 32 * ssi + r;
#pragma unroll
            for (int i = 0; i < 16; ++i) { const int t = 32 * sti + (i & 3) + 8 * (i >> 2) + 4 * h;
                *(LAS bf16*)(Sc + t * LD64 + 2 * s) = (bf16)f2bf(s <= t ? sc[i] : 0.f); }
        } else s_update();
        LBAR();
        f32x16 oa;
#pragma unroll
        for (int i = 0; i < 16; ++i) oa[i] = 0.f;
#pragma unroll
        for (int ks = 0; ks < 8; ++ks) oa = MFMA32(ldfrag(Qh, 32 * oti + r, LD128, 32 * ks + 16 * h), ldfrag(St, 32 * ovi + r, LD128, 32 * ks + 16 * h), oa);
#pragma unroll
        for (int ks = 0; ks < 4; ++ks) oa = MFMA32(ldfrag(Sc, 32 * oti + r, LD64, 32 * ks + 16 * h), ldfrag(iT, 32 * ovi + r, LD64, 32 * ks + 16 * h), oa);
        if (wave < 4) s_update();
        LBAR();
#pragma unroll
        for (int i = 0; i < 16; ++i) Ob[(32 * oti + (i & 3) + 8 * (i >> 2) + 4 * h) * LDO + 32 * ovi + r] = oa[i];
#pragma unroll
        for (int g = 0; g < 4; ++g) {
            const int k0 = 32 * ki + 8 * g + 4 * h;
            *(LAS v2u*)(St + (32 * vj0 + r) * LD128 + 2 * k0) = (v2u){pk2(S0[4 * g], S0[4 * g + 1]), pk2(S0[4 * g + 2], S0[4 * g + 3])};
            *(LAS v2u*)(St + (32 * (vj0 + 1) + r) * LD128 + 2 * k0) = (v2u){pk2(S1[4 * g], S1[4 * g + 1]), pk2(S1[4 * g + 2], S1[4 * g + 3])};
        }
        LBAR();
#pragma unroll
        for (int j = 0; j < 8; ++j) {
            const int t = 8 * wave + j;
            const float o0 = Ob[t * LDO + ln], o1 = Ob[t * LDO + 64 + ln];
            const float rs = __builtin_amdgcn_rsqf(wave_sum(o0 * o0 + o1 * o1) * (1.0f / 128.0f) + 1e-5f);
            const float g0 = og[2 * j], g1 = og[2 * j + 1];
            bf16* yo = y + (mbase + (size_t)c * 64 + t) * D + Y_HG + hh * 128;
            yo[ln] = (bf16)f2bf(o0 * rs * nw0 * (g0 * sigm(g0)));
            yo[64 + ln] = (bf16)f2bf(o1 * rs * nw1 * (g1 * sigm(g1)));
        }
        LBAR();
    }
}

__device__ __forceinline__ void wave_sum8(LAS float* scr, int ln, const float (&v)[8], float (&tot)[8]) {
#pragma unroll
    for (int q = 0; q < 8; ++q) scr[q * 64 + ln] = v[q];
    asm volatile("" ::: "memory");
    const LAS float* src = scr + (ln >> 3) * 64 + (ln & 7) * 8;
    const f32x4 a = *(const LAS f32x4*)src, b = *(const LAS f32x4*)(src + 4);
    float s = ((a[0] + a[1]) + (a[2] + a[3])) + ((b[0] + b[1]) + (b[2] + b[3]));
    s += dpp_mov<0xB1>(s); s += dpp_mov<0x4E>(s); s += dpp_mov<0x141>(s);
#pragma unroll
    for (int q = 0; q < 8; ++q) tot[q] = __builtin_bit_cast(float, __builtin_amdgcn_readlane(__builtin_bit_cast(int, s), 8 * q));
    asm volatile("" ::: "memory");
}
#define MFMA16(a, b, c) __builtin_amdgcn_mfma_f32_16x16x32_bf16((a), (b), (c), 0, 0, 0)
__device__ __forceinline__ void rwkv_chain_mfma(LAS unsigned char* lds, PTab in, int l, int b, int hh, const bf16* proj, const bf16* lr, bf16* y, int tid, GBar gb) {
    constexpr int LD = 144, ASZ = 64 * LD, LDF = 68;
    constexpr int O_A = 0, O_R = ASZ, O_BT = 2 * ASZ, O_KT = 3 * ASZ, O_VT = 4 * ASZ, O_ST = 5 * ASZ, O_MK = 6 * ASZ, O_NB = 7 * ASZ, O_NK = 8 * ASZ, O_TT = 9 * ASZ, O_TTT = 10 * ASZ;
    constexpr int O_B = 11 * ASZ, O_K = 12 * ASZ, O_WT = O_B, O_UT = O_K, O_MF = 13 * ASZ, O_GL = O_MF + 64 * LDF * 4, O_PW = O_GL + 256, O_BON = O_PW + 2048, O_PT = O_BON + 256, O_END = O_PT + 3 * 16 * 48;
    static_assert(O_END <= MISC_OFF, "rwkv LDS map");
    const int lane = tid & 63, wave = __builtin_amdgcn_readfirstlane(tid >> 6);
    LAS unsigned char* A_ = lds + O_A; LAS unsigned char* R_ = lds + O_R; LAS unsigned char* BT = lds + O_BT; LAS unsigned char* KT = lds + O_KT; LAS unsigned char* VT = lds + O_VT;
    LAS unsigned char* ST = lds + O_ST; LAS unsigned char* MK = lds + O_MK; LAS unsigned char* NB = lds + O_NB; LAS unsigned char* NK = lds + O_NK; LAS unsigned char* TT = lds + O_TT;
    LAS unsigned char* TTt = lds + O_TTT; LAS unsigned char* B_ = lds + O_B; LAS unsigned char* K_ = lds + O_K; LAS unsigned char* WT = lds + O_WT; LAS unsigned char* UT = lds + O_UT;
    LAS float* MF = (LAS float*)(lds + O_MF); LAS float* GLs = (LAS float*)(lds + O_GL); LAS float* Pw = (LAS float*)(lds + O_PW); LAS float* Bon = (LAS float*)(lds + O_BON);
    LAS unsigned char* Pt = lds + O_PT;
    const int ch = hh * 64 + lane;
    const float* mu = in[6] + l * 3328;
    const float mu_r = mu[ch], mu_k = mu[1024 + ch], mu_v = mu[2048 + ch];
    const float w0 = in[8][l * RW + ch], a0 = in[10][l * RW + ch], kkc = in[12][l * RW + ch], kac = in[13][l * RW + ch], rkc = in[14][l * RW + ch];
    const float lnw = in[15][l * RW + ch], lnb = in[16][l * RW + ch];
    for (int i = tid; i < ASZ / 4; i += 512) { ((LAS unsigned*)ST)[i] = 0u; ((LAS unsigned*)TT)[i] = 0u; ((LAS unsigned*)TTt)[i] = 0u; }
    f32x16 X;
#pragma unroll
    for (int i = 0; i < 16; ++i) X[i] = 0.f;
    const size_t mbase = (size_t)b * T;
    unsigned pr[9], pk[9], pv[9], pwl[8], pal[8], pgl[8];
#define LDW(ptr) (*(const unsigned*)((ptr) + (lnx & ~1)))
#define bf2f_lo(u) __uint_as_float(((u) >> sh16) << 16)
    auto load_raw = [&](int c, int lnx) {
        const __amdgpu_buffer_rsrc_t rp = __builtin_amdgcn_make_buffer_rsrc((void*)proj, (short)0, 0x7ffffff0, 0x00020000), rq = __builtin_amdgcn_make_buffer_rsrc((void*)lr, (short)0, 0x7ffffff0, 0x00020000);
        const unsigned m0 = (unsigned)mbase + (unsigned)c * 64u + 8u * (unsigned)wave;
        const unsigned sp = m0 * (unsigned)(PW * 2) + (unsigned)hh * 128u, sq = m0 * (unsigned)(LRN * 2) + (unsigned)hh * 128u;
        const int vo = 2 * (lnx & ~1);
#define RB32(rs, so) ((unsigned)__builtin_amdgcn_raw_buffer_load_b32((rs), vo, (int)(so), 0))
        if (c == 0 && wave == 0) { pr[0] = 0; pk[0] = 0; pv[0] = 0; } else { const unsigned sm = sp - (unsigned)(PW * 2); pr[0] = RB32(rp, sm); pk[0] = RB32(rp, sm + 2048u); pv[0] = RB32(rp, sm + 4096u); }
#pragma unroll
        for (int j = 0; j < 8; ++j) { const unsigned spj = sp + (unsigned)(j * PW * 2), sqj = sq + (unsigned)(j * LRN * 2);
            pr[j + 1] = RB32(rp, spj); pk[j + 1] = RB32(rp, spj + 2048u); pv[j + 1] = RB32(rp, spj + 4096u);
            pwl[j] = RB32(rq, sqj); pal[j] = RB32(rq, sqj + 2048u); pgl[j] = RB32(rq, sqj + 4096u); }
#undef RB32
    };
    load_raw(0, lane);
    __syncthreads();
    for (int c = 0; c < T / 64; ++c) {
        if (c == SEG_C1 || c == SEG_C2 || c == SEG_C3) grid_sync(gb);
        int ln = lane; asm volatile("" : "+v"(ln));
        const int r = ln & 31, h = ln >> 5;
        const int sh16 = (ln & 1) * 16;
        const int lf = r * LD + 16 * h, lm = (4 * h * LDF + r) * 4, lmt = (r * LDF + 4 * h) * 4, lt = r * LD + 8 * h, lp = 2 * ln, lq = ln * LD;
#define FR(arr, tile, ks) (*(const LAS bf16x8*)((arr) + (32 * (tile)) * LD + 32 * (ks) + lf))
        float vj[8], gj[8], bj[8];
        LAS float* rscr = (LAS float*)(lds + O_B) + wave * 528;
        {
            float rj[8], kmj[8], kkj[8], aj[8], cg[8];
            float run = 0.f;
            float pn[8], pb[8];
#pragma unroll
            for (int j = 0; j < 8; ++j) {
                const float rc = bf2f_lo(pr[j + 1]), kc = bf2f_lo(pk[j + 1]), vc = bf2f_lo(pv[j + 1]);
                const float rr = rc + (bf2f_lo(pr[j]) - rc) * mu_r, kx = kc + (bf2f_lo(pk[j]) - kc) * mu_k, vv = vc + (bf2f_lo(pv[j]) - vc) * mu_v;
                const float lw = -0.6065306597f * sigm(w0 + bf2f_lo(pwl[j]));
                const float a = sigm(a0 + bf2f_lo(pal[j]));
                const float kk = kx * kkc, km = kx * (1.0f + (a - 1.0f) * kac);
                pn[j] = kk * kk; pb[j] = rr * km * rkc;
                run += lw; cg[j] = run;
                rj[j] = rr; kmj[j] = km; kkj[j] = kk; aj[j] = a; vj[j] = vv; gj[j] = bf2f_lo(pgl[j]);
            }
            float nt[8];
            wave_sum8(rscr, ln, pn, nt); wave_sum8(rscr, ln, pb, bj);
#pragma unroll
            for (int j = 0; j < 8; ++j) kkj[j] *= fminf(__builtin_amdgcn_rsqf(nt[j]), 1e12f);
            Pw[wave * 64 + ln] = run;
            LBAR();
            float pre = 0.f, tot = 0.f;
#pragma unroll
            for (int w2 = 0; w2 < 8; ++w2) { const float pw2 = Pw[w2 * 64 + ln]; tot += pw2; if (w2 < wave) pre += pw2; }
            unsigned btp[4], ktp[4], vtp[4];
            float eprev = __expf(pre);
#pragma unroll
            for (int j = 0; j < 8; j += 2) {
                float bt2[2], kt2[2];
#pragma unroll
                for (int e = 0; e < 2; ++e) {
                    const int t = 8 * wave + j + e;
                    const float eG = __expf(pre + cg[j + e]), enG = __builtin_amdgcn_rcpf(eG);
                    bt2[e] = kkj[j + e] * aj[j + e] * enG; kt2[e] = kmj[j + e] * enG;
                    *(LAS bf16*)(A_ + t * LD + lp) = (bf16)f2bf(-kkj[j + e] * eprev);
                    *(LAS bf16*)(B_ + t * LD + lp) = (bf16)f2bf(bt2[e]);
                    *(LAS bf16*)(K_ + t * LD + lp) = (bf16)f2bf(kt2[e]);
                    *(LAS bf16*)(R_ + t * LD + lp) = (bf16)f2bf(rj[j + e] * eG);
                    eprev = eG;
                }
                btp[j >> 1] = pk2(bt2[0], bt2[1]); ktp[j >> 1] = pk2(kt2[0], kt2[1]); vtp[j >> 1] = pk2(vj[j], vj[j + 1]);
            }
            *(LAS v4u*)(BT + lq + 16 * wave) = (v4u){btp[0], btp[1], btp[2], btp[3]};
            *(LAS v4u*)(KT + lq + 16 * wave) = (v4u){ktp[0], ktp[1], ktp[2], ktp[3]};
            *(LAS v4u*)(VT + lq + 16 * wave) = (v4u){vtp[0], vtp[1], vtp[2], vtp[3]};
            if (wave == 0) GLs[ln] = __expf(tot);
        }
        LBAR();
        if (c + 1 < T / 64) load_raw(c + 1, ln);
        {
            const int p = wave >> 1, ti = wave & 1;
            const LAS unsigned char* Aop = (p < 2) ? A_ : R_; const LAS unsigned char* Bop = (p & 1) ? K_ : B_;
            const int t = 32 * ti + r, incl = (p >= 2) ? 1 : 0;
            LAS unsigned char* dst = (p == 1) ? MK : (p == 2) ? NB : NK;
#pragma unroll
            for (int si = 0; si < 2; ++si) {
                f32x16 acc;
#pragma unroll
                for (int i = 0; i < 16; ++i) acc[i] = 0.f;
                if (!(ti == 0 && si == 1)) {
#pragma unroll
                    for (int ks = 0; ks < 4; ++ks) acc = MFMA32(FR(Bop, si, ks), FR(Aop, ti, ks), acc);
                }
#pragma unroll
                for (int g = 0; g < 4; ++g) {
                    const int s0 = 32 * si + 8 * g + 4 * h;
                    const float m0 = (s0 < t + incl) ? acc[4 * g] : 0.f, m1 = (s0 + 1 < t + incl) ? acc[4 * g + 1] : 0.f, m2 = (s0 + 2 < t + incl) ? acc[4 * g + 2] : 0.f, m3 = (s0 + 3 < t + incl) ? acc[4 * g + 3] : 0.f;
                    if (p == 0) *(LAS f32x4*)((LAS unsigned char*)MF + ((32 * ti) * LDF + 32 * si + 8 * g) * 4 + lmt) = (f32x4){m0, m1, m2, m3};
                    else *(LAS v2u*)(dst + (32 * ti) * LD + 64 * si + 16 * g + lt) = (v2u){pk2(m0, m1), pk2(m2, m3)};
                }
            }
        }
        LBAR();
        const int ti4 = (wave >> 1) & 1, vi4 = wave & 1;
        if (wave < 4) {
            f32x16 acc;
#pragma unroll
            for (int i = 0; i < 16; ++i) acc[i] = 0.f;
#pragma unroll
            for (int ks = 0; ks < 4; ++ks) acc = MFMA32(FR(MK, ti4, ks), FR(VT, vi4, ks), acc);
#pragma unroll
            for (int ks = 0; ks < 4; ++ks) acc = MFMA32(FR(A_, ti4, ks), FR(ST, vi4, ks), acc);
#pragma unroll
            for (int g = 0; g < 4; ++g)
                *(LAS v2u*)(WT + (32 * vi4) * LD + 64 * ti4 + 16 * g + lt) = (v2u){pk2(acc[4 * g], acc[4 * g + 1]), pk2(acc[4 * g + 2], acc[4 * g + 3])};
        } else if (wave == 4) {
            const int l15 = ln & 15, g4 = ln >> 4;
            float x[16];
#pragma unroll
            for (int i = 0; i < 16; ++i) x[i] = 0.f;
#pragma unroll
            for (int i = 0; i < 16; ++i) {
                float s = (i == l15) ? 1.0f : 0.0f;
#pragma unroll
                for (int mq = 0; mq < (i + 3) / 4; ++mq) {
                    const f32x4 m4 = *(const LAS f32x4*)(MF + (16 * g4 + i) * LDF + 16 * g4 + 4 * mq);
                    s += m4[0] * x[4 * mq] + m4[1] * x[4 * mq + 1] + m4[2] * x[4 * mq + 2] + m4[3] * x[4 * mq + 3];
                }
                if ((i & 3) == 3) asm volatile("" : "+v"(s) :: "memory");
                x[i] = s;
            }
#pragma unroll
            for (int i = 0; i < 16; ++i) *(LAS bf16*)(TT + (16 * g4 + i) * LD + 2 * (16 * g4 + l15)) = (bf16)f2bf(x[i]);
            *(LAS v4u*)(TTt + (16 * g4 + l15) * LD + 2 * (16 * g4)) = (v4u){pk2(x[0], x[1]), pk2(x[2], x[3]), pk2(x[4], x[5]), pk2(x[6], x[7])};
            *(LAS v4u*)(TTt + (16 * g4 + l15) * LD + 2 * (16 * g4) + 16) = (v4u){pk2(x[8], x[9]), pk2(x[10], x[11]), pk2(x[12], x[13]), pk2(x[14], x[15])};
        }
        auto merge = [&](int bi, int bjj) {
            const int l15 = ln & 15, g4 = ln >> 4, d = bi - bjj;
            LAS unsigned char* Ptw = Pt + 768 * (wave - 5);
            f32x4 P = {0.f, 0.f, 0.f, 0.f};
            const bf16x8 zf = {0, 0, 0, 0, 0, 0, 0, 0};
#pragma unroll
            for (int ks = 0; ks < 2; ++ks) {
                if (32 * ks < 16 * d) {
                    const int kq = 32 * ks + 8 * g4;
                    bf16x8 af = zf, bfr = zf;
                    if (kq < 16 * d) {
                        const f32x4 m0 = *(const LAS f32x4*)(MF + (16 * bi + l15) * LDF + 16 * bjj + kq), m1 = *(const LAS f32x4*)(MF + (16 * bi + l15) * LDF + 16 * bjj + kq + 4);
                        const v4u pa = (v4u){pk2(m0[0], m0[1]), pk2(m0[2], m0[3]), pk2(m1[0], m1[1]), pk2(m1[2], m1[3])};
                        af = __builtin_bit_cast(bf16x8, pa);
                        bfr = *(const LAS bf16x8*)(TTt + (16 * bjj + l15) * LD + 2 * (16 * bjj + kq));
                    }
                    P = MFMA16(af, bfr, P);
                }
            }
            *(LAS v2u*)(Ptw + l15 * 48 + 8 * g4) = (v2u){pk2(P[0], P[1]), pk2(P[2], P[3])};
            LDS_WAIT(); asm volatile("" ::: "memory");
            bf16x8 a2 = zf, b2 = zf;
            if (g4 < 2) { a2 = *(const LAS bf16x8*)(TT + (16 * bi + l15) * LD + 2 * (16 * bi + 8 * g4)); b2 = *(const LAS bf16x8*)(Ptw + l15 * 48 + 16 * g4); }
            const f32x4 zero4 = {0.f, 0.f, 0.f, 0.f}; const f32x4 Tij = MFMA16(a2, b2, zero4);
#pragma unroll
            for (int e = 0; e < 4; ++e) *(LAS bf16*)(TT + (16 * bi + 4 * g4 + e) * LD + 2 * (16 * bjj + l15)) = (bf16)f2bf(Tij[e]);
            *(LAS v2u*)(TTt + (16 * bjj + l15) * LD + 2 * (16 * bi + 4 * g4)) = (v2u){pk2(Tij[0], Tij[1]), pk2(Tij[2], Tij[3])};
        };
        LBAR();
        if (wave >= 5) merge(wave - 4, wave - 5);
        LBAR();
        if (wave == 5 || wave == 6) merge(wave - 3, wave - 5);
        LBAR();
        if (wave == 5) merge(3, 0);
        LBAR();
        if (wave < 4) {
            f32x16 acc;
#pragma unroll
            for (int i = 0; i < 16; ++i) acc[i] = 0.f;
#pragma unroll
            for (int ks = 0; ks < 4; ++ks) if (ks < 2 * (ti4 + 1)) acc = MFMA32(FR(TT, ti4, ks), FR(WT, vi4, ks), acc);
#pragma unroll
            for (int g = 0; g < 4; ++g)
                *(LAS v2u*)(UT + (32 * vi4) * LD + 64 * ti4 + 16 * g + lt) = (v2u){pk2(acc[4 * g], acc[4 * g + 1]), pk2(acc[4 * g + 2], acc[4 * g + 3])};
        }
        LBAR();
        if (wave < 4) {
            f32x16 acc;
#pragma unroll
            for (int i = 0; i < 16; ++i) acc[i] = 0.f;
#pragma unroll
            for (int ks = 0; ks < 4; ++ks) acc = MFMA32(FR(R_, ti4, ks), FR(ST, vi4, ks), acc);
#pragma unroll
            for (int ks = 0; ks < 4; ++ks) if (ks < 2 * (ti4 + 1)) acc = MFMA32(FR(NB, ti4, ks), FR(UT, vi4, ks), acc);
#pragma unroll
            for (int ks = 0; ks < 4; ++ks) if (ks < 2 * (ti4 + 1)) acc = MFMA32(FR(NK, ti4, ks), FR(VT, vi4, ks), acc);
#pragma unroll
            for (int i = 0; i < 16; ++i) *(LAS float*)((LAS unsigned char*)MF + ((32 * ti4 + (i & 3) + 8 * (i >> 2)) * LDF + 32 * vi4) * 4 + lm) = acc[i];
        } else {
#pragma unroll
            for (int ks = 0; ks < 4; ++ks) X = MFMA32(FR(BT, ti4, ks), FR(UT, vi4, ks), X);
#pragma unroll
            for (int ks = 0; ks < 4; ++ks) X = MFMA32(FR(KT, ti4, ks), FR(VT, vi4, ks), X);
#pragma unroll
            for (int g = 0; g < 4; ++g) { const f32x4 e = *(const LAS f32x4*)(GLs + 32 * ti4 + 8 * g + 4 * h);
#pragma unroll
                for (int q = 0; q < 4; ++q) X[4 * g + q] *= e[q]; }
        }
        LBAR();
        if (wave >= 4) {
#pragma unroll
            for (int g = 0; g < 4; ++g)
                *(LAS v2u*)(ST + (32 * vi4) * LD + 64 * ti4 + 16 * g + lt) = (v2u){pk2(X[4 * g], X[4 * g + 1]), pk2(X[4 * g + 2], X[4 * g + 3])};
        }
        {
            float ov[8], o2[8], s1[8], s2[8];
#pragma unroll
            for (int j = 0; j < 8; ++j) { ov[j] = MF[(8 * wave + j) * LDF + ln]; o2[j] = ov[j] * ov[j]; }
            wave_sum8(rscr, ln, ov, s1); wave_sum8(rscr, ln, o2, s2);
            bf16* yrow = y + (mbase + (size_t)c * 64 + 8 * wave) * D + hh * 64;
#pragma unroll
            for (int j = 0; j < 8; ++j) {
                const float mean = s1[j] * (1.0f / 64.0f), var = fmaxf(s2[j] * (1.0f / 64.0f) - mean * mean, 0.f);
                const float on = (ov[j] - mean) * __builtin_amdgcn_rsqf(var + 64e-5f) * lnw + lnb;
                (yrow + (size_t)j * D)[ln] = (bf16)f2bf((on + bj[j] * vj[j]) * gj[j]);
            }
        }
#undef FR
    }
    __syncthreads();
#undef LDW
#undef bf2f_lo
}

__device__ __forceinline__ void lowrank_tile(LAS unsigned char* lds, PTab in, int l, const bf16* proj, const bf16* wlr, bf16* lr, int tile, int tid) {
    constexpr int LDA = 528, LDS_ST = 144;
    const int lane = tid & 63, wave = __builtin_amdgcn_readfirstlane(tid >> 6), r = lane & 31, h = lane >> 5;
    LAS unsigned char* At = lds; LAS unsigned char* stg = lds + 128 * LDA + wave * (32 * LDS_ST);
    const int m0 = tile * 128;
    {
        const f32x4 mu4 = *(const f32x4*)(in[6] + l * 3328 + P_LR + 4 * lane);
        const int rbase = 16 * wave;
        const bf16* pr = proj + (size_t)(m0 + rbase) * PW + P_LR + 4 * lane;
        v2u pu = (v2u){0u, 0u}; if (((m0 + rbase) & (T - 1)) != 0) pu = *(const v2u*)(pr - PW);
#pragma unroll 4
        for (int i = 0; i < 16; ++i) {
            const v2u cu = *(const v2u*)(pr + (size_t)i * PW);
            float xv[4] = {bflo(cu.x), bfhi(cu.x), bflo(cu.y), bfhi(cu.y)}; const float pv[4] = {bflo(pu.x), bfhi(pu.x), bflo(pu.y), bfhi(pu.y)};
#pragma unroll
            for (int j = 0; j < 4; ++j) { float xx = xv[j] + (pv[j] - xv[j]) * mu4[j];
                if (lane < 16) xx = 1.0f - 2.0f * __builtin_amdgcn_rcpf(1.0f + __expf(2.0f * xx)); else if (lane >= 32) xx = sigm(xx); xv[j] = xx; }
            *(LAS v2u*)(At + (rbase + i) * LDA + 8 * lane) = (v2u){pk2(xv[0], xv[1]), pk2(xv[2], xv[3])};
            pu = cu;
        }
    }
    __syncthreads();
#pragma unroll
    for (int q = 0; q < 6; ++q) {
        constexpr int dummy = 0; (void)dummy;
        const int grp = (q < 2) ? 0 : (q < 4) ? 1 : 2, kbase = (grp == 0) ? 0 : (grp == 1) ? 64 : 128, nks = (grp == 2) ? 8 : 4;
        const int n0 = 64 * (wave + 8 * q);
        bf16x8 wf[2][8];
#pragma unroll
        for (int t2 = 0; t2 < 2; ++t2)
#pragma unroll
            for (int ks = 0; ks < 8; ++ks) if (ks < nks) wf[t2][ks] = *(const bf16x8*)(wlr + (size_t)(n0 + 32 * t2 + r) * LRK + kbase + 16 * ks + 8 * h);
#pragma unroll 1
        for (int tt = 0; tt < 4; ++tt) {
            f32x16 a0, a1;
#pragma unroll
            for (int i = 0; i < 16; ++i) { a0[i] = 0.f; a1[i] = 0.f; }
#pragma unroll
            for (int ks = 0; ks < 8; ++ks) if (ks < nks) {
                const bf16x8 af = *(const LAS bf16x8*)(At + (32 * tt + r) * LDA + (kbase + 16 * ks + 8 * h) * 2);
                a0 = MFMA32(wf[0][ks], af, a0); a1 = MFMA32(wf[1][ks], af, a1);
            }
#pragma unroll
            for (int g = 0; g < 4; ++g) {
                *(LAS v2u*)(stg + r * LDS_ST + 16 * g + 8 * h) = (v2u){pk2(a0[4 * g], a0[4 * g + 1]), pk2(a0[4 * g + 2], a0[4 * g + 3])};
                *(LAS v2u*)(stg + r * LDS_ST + 64 + 16 * g + 8 * h) = (v2u){pk2(a1[4 * g], a1[4 * g + 1]), pk2(a1[4 * g + 2], a1[4 * g + 3])};
            }
            asm volatile("" ::: "memory");
#pragma unroll
            for (int it = 0; it < 4; ++it) {
                const int row = it * 8 + (lane >> 3);
                const v4u v = *(const LAS v4u*)(stg + row * LDS_ST + 16 * (lane & 7));
                *(v4u*)(lr + (size_t)(m0 + 32 * tt + row) * LRN + n0 + 8 * (lane & 7)) = v;
            }
            asm volatile("" ::: "memory");
        }
    }
    __syncthreads();
}

__device__ __forceinline__ void cvt_item(const float* W, int K, int N, const float* gain, bf16* WT, bool gu, LAS float* scr, int item, int lane) {
    const int nblk = N / 32, kb = item / nblk, nb = item - kb * nblk, k0 = 64 * kb, n0 = 32 * nb;
    float wv[32];
    const float* wp = W + (size_t)(k0 + (lane >> 5)) * N + n0 + (lane & 31);
#pragma unroll
    for (int i = 0; i < 32; ++i) wv[i] = wp[(size_t)(2 * i) * N];
#pragma unroll
    for (int i = 0; i < 32; ++i) { const int kk = 2 * i + (lane >> 5); const float g = gain ? gain[k0 + kk] : 1.0f; scr[kk * 33 + (lane & 31)] = wv[i] * g; }
    LDS_WAIT(); asm volatile("" ::: "memory");
    int r0 = n0;
    if (gu) { if (n0 < FF) r0 = 256 * (n0 / 128) + (n0 % 128); else { const int n1 = n0 - FF; r0 = 256 * (n1 / 128) + 128 + (n1 % 128); } }
    const int c = lane & 7;
#pragma unroll
    for (int j = 0; j < 4; ++j) { const int n = (lane >> 3) + 8 * j; const LAS float* s = scr + (8 * c) * 33 + n;
        v4u o; o.x = pk2(s[0 * 33], s[1 * 33]); o.y = pk2(s[2 * 33], s[3 * 33]); o.z = pk2(s[4 * 33], s[5 * 33]); o.w = pk2(s[6 * 33], s[7 * 33]);
        *(v4u*)(WT + (size_t)(r0 + n) * K + k0 + 8 * c) = o; }
    LDS_WAIT(); asm volatile("" ::: "memory");
}

__device__ __forceinline__ void rwkv_chain(LAS unsigned char* lds, PTab in, int l, int b, int h, const bf16* proj, const bf16* lr, bf16* y, int lane, int wave) {
    constexpr int TC = 32;
    LAS float* sR = (LAS float*)lds; LAS float* sW = sR + TC * 64; LAS float* sK = sW + TC * 64; LAS float* sV = sK + TC * 64;
    LAS float* sA = sV + TC * 64; LAS float* sB = sA + TC * 64; LAS float* sO = sB + TC * 64; LAS float* sBon = sO + TC * 64;
    const int ch = h * 64 + lane;
    const float* mu = in[6] + l * 3328;
    const float mu_r = mu[ch], mu_k = mu[1024 + ch], mu_v = mu[2048 + ch];
    const float w0 = in[8][l * RW + ch], a0 = in[10][l * RW + ch], kkc = in[12][l * RW + ch], kac = in[13][l * RW + ch], rkc = in[14][l * RW + ch];
    const float lnw = in[15][l * RW + ch], lnb = in[16][l * RW + ch];
    float S[8];
#pragma unroll
    for (int j = 0; j < 8; ++j) S[j] = 0.f;
    const int rowl = lane >> 3, kp = lane & 7;
    for (int c = 0; c < T / TC; ++c) {
#pragma unroll
        for (int i = 0; i < TC / 8; ++i) {
            const int tt = wave * (TC / 8) + i, t = c * TC + tt; const size_t m = (size_t)b * T + t;
            const bf16* pr = proj + m * PW; const bf16* lq = lr + m * LRN;
            const float rc = bf2f(pr[ch]), kc = bf2f(pr[1024 + ch]), vc = bf2f(pr[2048 + ch]);
            float rp = 0.f, kq0 = 0.f, vp = 0.f;
            if (t > 0) { const bf16* pp = pr - PW; rp = bf2f(pp[ch]); kq0 = bf2f(pp[1024 + ch]); vp = bf2f(pp[2048 + ch]); }
            const float r = rc + (rp - rc) * mu_r, k = kc + (kq0 - kc) * mu_k, v = vc + (vp - vc) * mu_v;
            const float wl = bf2f(lq[ch]), al = bf2f(lq[1024 + ch]);
            const float decay = __expf(-0.6065306597f * sigm(w0 + wl));
            const float a = sigm(a0 + al);
            float kk = k * kkc; const float nrm = sqrtf(wave_sum(kk * kk)); kk = kk / fmaxf(nrm, 1e-12f);
            const float kq = k * (1.0f + (a - 1.0f) * kac);
            const float bon = wave_sum(r * kq * rkc);
            sR[tt * 64 + lane] = r; sW[tt * 64 + lane] = decay; sK[tt * 64 + lane] = kq; sV[tt * 64 + lane] = v; sA[tt * 64 + lane] = -kk; sB[tt * 64 + lane] = kk * a;
            if (lane == 0) sBon[tt] = bon;
        }
        __syncthreads();
#pragma unroll 2
        for (int tt = 0; tt < TC; ++tt) {
            const int o8 = tt * 64 + kp * 8;
            const f32x4 a0v = *(const LAS f32x4*)(sA + o8), a1v = *(const LAS f32x4*)(sA + o8 + 4);
            const f32x4 w0v = *(const LAS f32x4*)(sW + o8), w1v = *(const LAS f32x4*)(sW + o8 + 4);
            const f32x4 b0v = *(const LAS f32x4*)(sB + o8), b1v = *(const LAS f32x4*)(sB + o8 + 4);
            const f32x4 k0v = *(const LAS f32x4*)(sK + o8), k1v = *(const LAS f32x4*)(sK + o8 + 4);
            const f32x4 r0v = *(const LAS f32x4*)(sR + o8), r1v = *(const LAS f32x4*)(sR + o8 + 4);
            const float vv = sV[tt * 64 + wave * 8 + rowl];
            float sa = 0.f;
#pragma unroll
            for (int j = 0; j < 4; ++j) { sa = fmaf(S[j], a0v[j], sa); sa = fmaf(S[4 + j], a1v[j], sa); }
            sa = sum8(sa);
#pragma unroll
            for (int j = 0; j < 4; ++j) {
                S[j] = fmaf(S[j], w0v[j], fmaf(sa, b0v[j], vv * k0v[j]));
                S[4 + j] = fmaf(S[4 + j], w1v[j], fmaf(sa, b1v[j], vv * k1v[j]));
            }
            float o = 0.f;
#pragma unroll
            for (int j = 0; j < 4; ++j) { o = fmaf(S[j], r0v[j], o); o = fmaf(S[4 + j], r1v[j], o); }
            o = sum8(o);
            if (kp == 0) sO[tt * 64 + wave * 8 + rowl] = o;
        }
        __syncthreads();
#pragma unroll
        for (int i = 0; i < TC / 8; ++i) {
            const int tt = wave * (TC / 8) + i, t = c * TC + tt; const size_t m = (size_t)b * T + t;
            const float o = sO[tt * 64 + lane];
            const float mean = wave_sum(o) * (1.0f / 64.0f); const float d = o - mean;
            const float var = wave_sum(d * d) * (1.0f / 64.0f);
            const float on = d * rsqrtf(var + 64e-5f) * lnw + lnb;
            const float g = bf2f(lr[m * LRN + 2048 + ch]);
            const float yv = (on + sBon[tt] * sV[tt * 64 + lane]) * g;
            y[m * D + ch] = (bf16)f2bf(yv);
        }
        __syncthreads();
    }
}
__device__ __forceinline__ void hgrn_chain(LAS unsigned char* lds, PTab in, int l, int b, int h, const bf16* proj, bf16* y, int lane, int wave) {
    constexpr int TC = 16;
    LAS float* sQ = (LAS float*)lds; LAS float* sF = sQ + TC * 128; LAS float* sKK = sF + TC * 128; LAS float* sI = sKK + TC * 128; LAS float* sOP = sI + TC * 128;
    float lb[2], nw[2];
#pragma unroll
    for (int e = 0; e < 2; ++e) {
        const int cc = h * 128 + lane + 64 * e;
        const float* hlb = in[18]; const float x0 = hlb[cc], x1 = hlb[512 + cc], x2 = hlb[1024 + cc], x3 = hlb[1536 + cc];
        const float mx = fmaxf(fmaxf(x0, x1), fmaxf(x2, x3));
        const float e0 = expf(x0 - mx), e1 = expf(x1 - mx), e2 = expf(x2 - mx), e3 = expf(x3 - mx);
        const float inv = 1.0f / (e0 + e1 + e2 + e3);
        float acc = 0.f; if (l >= 1) acc += e1; if (l >= 2) acc += e2; if (l >= 3) acc += e3;
        lb[e] = acc * inv;
        nw[e] = in[19][l * 512 + cc];
    }
    float S0[16], S1[16];
#pragma unroll
    for (int j = 0; j < 16; ++j) { S0[j] = 0.f; S1[j] = 0.f; }
    for (int c = 0; c < T / TC; ++c) {
#pragma unroll
        for (int i = 0; i < TC / 8; ++i) {
            const int tt = wave * (TC / 8) + i, t = c * TC + tt; const size_t m = (size_t)b * T + t;
            const bf16* pr = proj + m * PW + P_HG + h * 128;
#pragma unroll
            for (int e = 0; e < 2; ++e) {
                const int cc = lane + 64 * e;
                const float qr = bf2f(pr[cc]), fr = bf2f(pr[512 + cc]), iv = bf2f(pr[1024 + cc]);
                const float sg = sigm(fr);
                sQ[tt * 128 + cc] = qr * sigm(qr);
                sF[tt * 128 + cc] = fmaxf(lb[e] + (1.0f - lb[e]) * sg, 1e-30f);
                sKK[tt * 128 + cc] = (1.0f - lb[e]) * (1.0f - sg);
                sI[tt * 128 + cc] = iv;
            }
        }
        __syncthreads();
#pragma unroll 2
        for (int tt = 0; tt < TC; ++tt) {
            const int o16 = tt * 128 + wave * 16;
            f32x4 f4[4], k4[4], q4[4];
#pragma unroll
            for (int u = 0; u < 4; ++u) { f4[u] = *(const LAS f32x4*)(sF + o16 + 4 * u); k4[u] = *(const LAS f32x4*)(sKK + o16 + 4 * u); q4[u] = *(const LAS f32x4*)(sQ + o16 + 4 * u); }
            const float i0 = sI[tt * 128 + lane], i1 = sI[tt * 128 + 64 + lane];
            float o0 = 0.f, o1 = 0.f;
#pragma unroll
            for (int u = 0; u < 4; ++u)
#pragma unroll
                for (int j = 0; j < 4; ++j) {
                    S0[4 * u + j] = fmaf(f4[u][j], S0[4 * u + j], k4[u][j] * i0);
                    S1[4 * u + j] = fmaf(f4[u][j], S1[4 * u + j], k4[u][j] * i1);
                    o0 = fmaf(q4[u][j], S0[4 * u + j], o0); o1 = fmaf(q4[u][j], S1[4 * u + j], o1);
                }
            sOP[(tt * 8 + wave) * 128 + lane] = o0; sOP[(tt * 8 + wave) * 128 + 64 + lane] = o1;
        }
        __syncthreads();
#pragma unroll
        for (int i = 0; i < TC / 8; ++i) {
            const int tt = wave * (TC / 8) + i, t = c * TC + tt; const size_t m = (size_t)b * T + t;
            float o0 = 0.f, o1 = 0.f;
#pragma unroll
            for (int w = 0; w < 8; ++w) { o0 += sOP[(tt * 8 + w) * 128 + lane]; o1 += sOP[(tt * 8 + w) * 128 + 64 + lane]; }
            const float ms = wave_sum(o0 * o0 + o1 * o1) * (1.0f / 128.0f);
            const float rs = rsqrtf(ms + 1e-5f);
            const bf16* pg = proj + m * PW + P_HG + 1536 + h * 128;
            const float g0 = bf2f(pg[lane]), g1 = bf2f(pg[64 + lane]);
            bf16* yo = y + m * D + Y_HG + h * 128;
            yo[lane] = (bf16)f2bf(o0 * rs * nw[0] * (g0 * sigm(g0)));
            yo[64 + lane] = (bf16)f2bf(o1 * rs * nw[1] * (g1 * sigm(g1)));
        }
        __syncthreads();
    }
}
__device__ __forceinline__ void conv_rows(PTab in, int l, const bf16* proj, bf16* y, int slice, int nslices, int lane, int wave) {
    const float* cw = in[17] + l * 3 * 512;
    float w0[8], w1[8], w2[8];
#pragma unroll
    for (int j = 0; j < 8; ++j) { w0[j] = cw[8 * lane + j]; w1[j] = cw[512 + 8 * lane + j]; w2[j] = cw[1024 + 8 * lane + j]; }
    for (int m = slice * NWAVES + wave; m < M; m += nslices * NWAVES) {
        const int t = m & (T - 1);
        const bf16* pr = proj + (size_t)m * PW + P_CONV + 8 * lane;
        const v4u c2 = *(const v4u*)pr, x2 = *(const v4u*)(pr + 512), bg = *(const v4u*)(pr + 1024);
        v4u c1 = (v4u){0u, 0u, 0u, 0u}, x1 = c1, c0 = c1, x0 = c1;
        if (t >= 1) { c1 = *(const v4u*)(pr - PW); x1 = *(const v4u*)(pr - PW + 512); }
        if (t >= 2) { c0 = *(const v4u*)(pr - 2 * PW); x0 = *(const v4u*)(pr - 2 * PW + 512); }
        v4u o;
#pragma unroll
        for (int q = 0; q < 4; ++q) {
            const float lo = bflo(bg[q]) * (bflo(c2[q]) * bflo(x2[q]) * w2[2 * q] + bflo(c1[q]) * bflo(x1[q]) * w1[2 * q] + bflo(c0[q]) * bflo(x0[q]) * w0[2 * q]);
            const float hi = bfhi(bg[q]) * (bfhi(c2[q]) * bfhi(x2[q]) * w2[2 * q + 1] + bfhi(c1[q]) * bfhi(x1[q]) * w1[2 * q + 1] + bfhi(c0[q]) * bfhi(x0[q]) * w0[2 * q + 1]);
            o[q] = pk2(lo, hi);
        }
        *(v4u*)(y + (size_t)m * D + Y_CONV + 8 * lane) = o;
    }
}


__device__ __forceinline__ void cvt_groups(PTab in, unsigned char* ws, LAS float* scr, int la, int lb, int w0, int nw, int lane) {
    constexpr int I_GU = (D / 64) * (2 * FF / 32), I_DN = (FF / 64) * (D / 32), I_IN = (D / 64) * (PW / 32), I_O = (D / 64) * (D / 32);
    if (lb >= 0) {
        for (int it = w0; it < I_O + I_GU + I_DN; it += nw) {
            int r = it;
            if (r < I_O) { cvt_item(in[20] + (size_t)lb * D * D, D, D, nullptr, (bf16*)(ws + W_OUT), false, scr, r, lane); continue; } r -= I_O;
            if (r < I_GU) { cvt_item(in[22] + (size_t)lb * D * 2 * FF, D, 2 * FF, in[21] + lb * D, (bf16*)(ws + W_GU2), true, scr, r, lane); continue; } r -= I_GU;
            cvt_item(in[23] + (size_t)lb * FF * D, FF, D, nullptr, (bf16*)(ws + W_D2), false, scr, r, lane);
        }
    }
    if (la >= 0) {
        for (int it = w0; it < I_GU + I_DN + I_IN; it += nw) {
            int r = it;
            if (r < I_GU) { cvt_item(in[2] + (size_t)la * D * 2 * FF, D, 2 * FF, in[1] + la * D, (bf16*)(ws + W_GU1), true, scr, r, lane); continue; } r -= I_GU;
            if (r < I_DN) { cvt_item(in[3] + (size_t)la * FF * D, FF, D, nullptr, (bf16*)(ws + W_D1), false, scr, r, lane); continue; } r -= I_DN;
            cvt_item(in[5] + (size_t)la * D * PW, D, PW, in[4] + la * D, (bf16*)(ws + W_IN), false, scr, r, lane);
        }
        bf16* wl = (bf16*)(ws + W_LR);
        const float* wup = in[7] + (size_t)la * 64 * RW; const float* aup = in[9] + (size_t)la * 64 * RW; const float* gup = in[11] + (size_t)la * 128 * RW;
        for (int idx = w0 * 64 + lane; idx < LRN * LRK; idx += nw * 64) {
            const int n = idx >> 8, k = idx & 255; float v = 0.f;
            if (n < 1024) { if (k < 64) v = wup[k * RW + n]; }
            else if (n < 2048) { if (k >= 64 && k < 128) v = aup[(k - 64) * RW + (n - 1024)]; }
            else { if (k >= 128) v = gup[(k - 128) * RW + (n - 2048)]; }
            wl[idx] = (bf16)f2bf(v);
        }
    }
}

struct Args { const float* in[25]; float* out; unsigned char* ws; int ph_lo, ph_hi; };
__global__ void __launch_bounds__(NWAVES * 64, 2) fwd(Args args) {
    extern __shared__ __attribute__((aligned(16))) unsigned char lds_raw[];
    LAS unsigned char* lds = (LAS unsigned char*)lds_raw;
    volatile LAS unsigned* MISC = (volatile LAS unsigned*)(lds + MISC_OFF);
    const int tid0 = threadIdx.x;
    const int wv0 = __builtin_amdgcn_readfirstlane(tid0 >> 6);
#if MK_N_LAUNCHES == 1
    constexpr int lo = 0, hi = NPH;
#else
    const int lo = args.ph_lo, hi = args.ph_hi;
#endif
    PTab in; in.t = (LAS unsigned long long*)(lds + PTAB_OFF);
    if (tid0 < 32) MISC[tid0] = 0u;
    if (tid0 == 0) {
#define PT_SET(i) in.t[i] = (unsigned long long)args.in[i]
        PT_SET(0); PT_SET(1); PT_SET(2); PT_SET(3); PT_SET(4); PT_SET(5); PT_SET(6); PT_SET(7); PT_SET(8); PT_SET(9); PT_SET(10); PT_SET(11); PT_SET(12);
        PT_SET(13); PT_SET(14); PT_SET(15); PT_SET(16); PT_SET(17); PT_SET(18); PT_SET(19); PT_SET(20); PT_SET(21); PT_SET(22); PT_SET(23); PT_SET(24);
#undef PT_SET
        in.t[25] = (unsigned long long)args.out; in.t[26] = (unsigned long long)args.ws;
    }
    __syncthreads();
    if (hi - lo > 1) (void)xcd_barrier_post((unsigned*)((unsigned char*)in[26] + WS_CTL) + CW_BAR, MISC + 8);
    int pc = 0;
#define PH_ON (pc >= lo && pc < hi)
#define PH_BEGIN int G = gridDim.x, bid = blockIdx.x, tid = wv0 * 64 + pg8::lane_id(); unsigned char* ws = (unsigned char*)in[26]; float* out = (float*)in[25]; \
    asm volatile("" : "+s"(G), "+s"(bid), "+v"(tid)); \
    const int lane = tid & 63, wave = __builtin_amdgcn_readfirstlane(tid >> 6); (void)lane; \
    const int gw = bid * NWAVES + wave, NGW = G * NWAVES; pg8::ssq_t* ssq = (pg8::ssq_t*)(ws + WS_SS); \
    bf16* HB = (bf16*)(ws + WS_HB); bf16* PROJ = (bf16*)(ws + WS_PROJ); bf16* ACT = (bf16*)(ws + WS_ACT); bf16* LRA = (bf16*)(ws + WS_LRA); bf16* LR = (bf16*)(ws + WS_LR); bf16* Y = (bf16*)(ws + WS_Y); \
    (void)gw; (void)NGW; (void)ssq; (void)HB; (void)PROJ; (void)ACT; (void)LRA; (void)LR; (void)Y; (void)out;
#define PH_END do { if (pc >= lo && pc + 1 < hi) { XcdBarrier bar_; bar_.bar = (unsigned*)((unsigned char*)in[26] + WS_CTL) + CW_BAR; bar_.x = xb_xcc_id(); bar_.st = MISC + 8; bar_.lead = (wv0 == 0) && (pg8::lane_id() == 0); xcd_barrier(bar_); } ++pc; } while (0)

    if (PH_ON) { PH_BEGIN
        const float* x = in[0];
        for (int m = gw; m < M; m += NGW) {
            const f32x4* xr = (const f32x4*)(x + (size_t)m * D) + lane; v2u* ho = (v2u*)(HB + (size_t)m * D) + lane;
            f32x4 v[8]; float s = 0.f;
#pragma unroll
            for (int j = 0; j < 8; ++j) { v[j] = xr[64 * j]; s += (v[j][0] * v[j][0] + v[j][1] * v[j][1]) + (v[j][2] * v[j][2] + v[j][3] * v[j][3]); }
#pragma unroll
            for (int j = 0; j < 8; ++j) { v2u o; o.x = pk2(v[j][0], v[j][1]); o.y = pk2(v[j][2], v[j][3]); ho[64 * j] = o; }
            s = wave_sum(s);
            if (lane == 0) ssq[m] = pg8::ssq_fix(s);
        }
        cvt_groups(in, ws, (LAS float*)(lds + wave * 16384), 0, -1, gw, NGW, lane);
    }
    PH_END;

    for (int l = 0; l < DEPTH; ++l) {
        for (int hf = 0; hf < 2; ++hf) {
            if (hf == 1) {
                if (PH_ON) { PH_BEGIN
                    pg8::Gemm g{HB, (const bf16*)(ws + W_IN), M, PW, D}; pg8::TailSplitOrder S; S.init(M, PW, G, bid);
                    pg8::EpiBf16S E{PROJ, PW, pg8::RstdCache{ssq + (size_t)(3 * l + 1) * M, (LAS float*)(lds + RING_BYTES) + wave * 128, -1}};
                    pg8::gemm_phase<pg8::EpiBf16S, pg8::TailSplitOrder, true, true>(lds, g, S, E, wave);
                }
                PH_END;
                if (PH_ON) { PH_BEGIN
                    for (int tile = bid; tile < M / 128; tile += G) { int tj = tid; asm volatile("" : "+v"(tj)); lowrank_tile(lds, in, l, PROJ, (const bf16*)(ws + W_LR), LR, tile, tj); }
                }
                PH_END;
                if (PH_ON) { PH_BEGIN
                    GBar gb; gb.bar = (unsigned*)(ws + WS_CTL) + CW_BAR; gb.st = MISC + 8; gb.wv = wave;
                    if (G == 256) {
                        const int job = bid;
                        if (job < 128) { const int tj = wave * 64 + pg8::lane_id(); rwkv_chain_mfma(lds, in, l, job >> 4, job & 15, PROJ, LR, Y, tj, gb); }
                        else if (job < 160) { const int tj = wave * 64 + pg8::lane_id(); hgrn_chain_mfma(lds, in, l, (job - 128) >> 2, (job - 128) & 3, PROJ, Y, tj, gb); }
                        else {
                            const int lj = pg8::lane_id();
                            conv_rows(in, l, PROJ, Y, job - 160, 96, lj, wave);
                            cvt_groups(in, ws, (LAS float*)(lds + wave * 16384), (l + 1 < DEPTH) ? l + 1 : -1, l, (job - 160) * NWAVES + wave, 96 * NWAVES, lj);
                            pg8::Gemm g{Y, (const bf16*)(ws + W_OUT), M, D, D};
                            pg8::EpiResid E{HB, ssq + (size_t)(3 * l + 2) * M, 1.0f};
                            for (int seg = 0; seg < 3; ++seg) {
                                grid_sync(gb);
                                const int j0 = (seg == 0) ? 0 : (seg == 1) ? SEG_J1 : SEG_J2, j1 = (seg == 0) ? SEG_J1 : (seg == 1) ? SEG_J2 : SEG_J3;
                                pg8::PanelOrder S{j0, j1 - j0, 96, (job & 7) * 12 + ((job - 160) >> 3)}; pg8::gemm_phase<pg8::EpiResid, pg8::PanelOrder, true, true>(lds, g, S, E, wave);
                            }
                        }
                        __syncthreads();
                    }
                }
                PH_END;
                if (PH_ON) { PH_BEGIN
                    pg8::Gemm g{Y, (const bf16*)(ws + W_OUT), M, D, D}; pg8::PanelOrder S{SEG_J3, 16 - SEG_J3, G, (G % 8 == 0) ? (bid & 7) * (G >> 3) + (bid >> 3) : bid};
                    pg8::EpiResid E{HB, ssq + (size_t)(3 * l + 2) * M, 1.0f};
                    pg8::gemm_phase<pg8::EpiResid, pg8::PanelOrder, true, true>(lds, g, S, E, wave);
                }
                PH_END;
            }
            if (PH_ON) { PH_BEGIN
                pg8::Gemm g{HB, (const bf16*)(ws + (hf ? W_GU2 : W_GU1)), M, 2 * FF, D}; pg8::TailSplitOrder S; S.init(M, 2 * FF, G, bid);
                pg8::EpiSwiGLU E{ACT, FF, pg8::RstdCache{ssq + (size_t)(3 * l + 2 * hf) * M, (LAS float*)(lds + RING_BYTES) + wave * 128, -1}};
                pg8::gemm_phase<pg8::EpiSwiGLU, pg8::TailSplitOrder, true, true>(lds, g, S, E, wave);
            }
            PH_END;
            if (PH_ON) { PH_BEGIN
                pg8::Gemm g{ACT, (const bf16*)(ws + (hf ? W_D2 : W_D1)), M, D, FF}; pg8::StaticOrder S; S.init(M, D, G, bid);
                pg8::EpiResid E{HB, ssq + (size_t)(3 * l + 2 * hf + 1) * M, 0.5f};
                pg8::gemm_phase<pg8::EpiResid, pg8::StaticOrder, true, true>(lds, g, S, E, wave);
            }
            PH_END;
        }
    }
    if (PH_ON) { PH_BEGIN
        const float* gn = in[24]; const pg8::ssq_t* s12 = ssq + (size_t)12 * M;
        f32x4 gv[8];
#pragma unroll
        for (int j = 0; j < 8; ++j) gv[j] = *((const f32x4*)gn + lane + 64 * j);
        for (int m = gw; m < M; m += NGW) {
            const float rs = pg8::rstd_of(s12, m);
            const v2u* hrow = (const v2u*)(HB + (size_t)m * D) + lane; f32x4* orow = (f32x4*)(out + (size_t)m * D) + lane;
#pragma unroll
            for (int j = 0; j < 8; ++j) { const v2u hv = hrow[64 * j]; const f32x4 v = {bflo(hv.x), bfhi(hv.x), bflo(hv.y), bfhi(hv.y)}; orow[64 * j] = v * rs * gv[j]; }
        }
    }
#undef PH_ON
#undef PH_END
}

extern "C" void kernel_launch(void* const* d_in, const int* in_sizes, int n_in, void* d_out, int out_size, void* d_ws, size_t ws_size, hipStream_t stream) {
    static int grid = 0;
    if (grid == 0) {
        if (n_in != 25 || in_sizes[0] != M * D || out_size != M * D || ws_size < WS_END) { fprintf(stderr, "kernel_launch: unexpected shapes (n_in %d, in0 %d, out %d, ws %zu; need ws >= %zu); nothing launched\n", n_in, n_in > 0 ? in_sizes[0] : -1, out_size, ws_size, (size_t)WS_END); grid = -1; return; }
        int dev = 0, cus = 0, per_cu = 0;
        if (hipGetDevice(&dev) != hipSuccess || hipDeviceGetAttribute(&cus, hipDeviceAttributeMultiprocessorCount, dev) != hipSuccess) { grid = -1; return; }
        if (hipFuncSetAttribute((const void*)fwd, hipFuncAttributeMaxDynamicSharedMemorySize, LDS_BYTES) != hipSuccess) { fprintf(stderr, "kernel_launch: hipFuncSetAttribute failed\n"); grid = -1; return; }
        if (hipOccupancyMaxActiveBlocksPerMultiprocessor(&per_cu, (const void*)fwd, NWAVES * 64, LDS_BYTES) != hipSuccess || per_cu < 1) { fprintf(stderr, "kernel_launch: occupancy query reports %d blocks per CU\n", per_cu); }
        (void)hipGetLastError();
        grid = cus;
    }
    if (grid < 0) return;
    if (hipMemsetAsync((char*)d_ws + WS_CTL, 0, ZERO_BYTES, stream) != hipSuccess) return;
    Args a{};
    for (int i = 0; i < 25; ++i) a.in[i] = (const float*)d_in[i];
    a.out = (float*)d_out; a.ws = (unsigned char*)d_ws;
#if MK_N_LAUNCHES == 1
    a.ph_lo = 0; a.ph_hi = NPH;
    hipLaunchKernelGGL(fwd, dim3(grid), dim3(NWAVES * 64), LDS_BYTES, stream, a);
#else
    for (int p = 0; p < NPH; ++p) { a.ph_lo = p; a.ph_hi = p + 1; hipLaunchKernelGGL(fwd, dim3(grid), dim3(NWAVES * 64), LDS_BYTES, stream, a); }
#endif
}
```

```cpp
#include <hip/hip_runtime.h>
#include <cstdio>
#include <cstdint>
#ifndef MK_N_LAUNCHES
#define MK_N_LAUNCHES 1
#endif
namespace pg8 {
#define PG8_LAS __attribute__((address_space(3)))
typedef unsigned short bf16_t;
typedef short bf16x8 __attribute__((ext_vector_type(8)));
typedef float f32x4 __attribute__((ext_vector_type(4)));
typedef unsigned u32x4 __attribute__((ext_vector_type(4)));
constexpr int BM = 256, BK = 64, HALF = 128, HTB = HALF * BK * 2  , STAGE_BYTES = 8 * HTB, NXCD = 8, WGM = 4;

__host__ __device__ __forceinline__ int lds_byte(int r, int c) { const int st = (r >> 4) * 2 + (c >> 5), rr = r & 15, cc = c & 31, ob = rr * 64 + cc * 2; return st * 1024 + (ob ^ (((ob >> 9) & 1) << 5)); }
__host__ __device__ __forceinline__ void stage_rc(int b, int& R, int& C) { const int st = b / 1024, sb = b % 1024, swz = sb ^ (((sb >> 9) & 1) << 5); R = (st >> 1) * 16 + swz / 64; C = (st & 1) * 32 + (swz % 64) / 2; }
__host__ __device__ __forceinline__ int perm32(int rho) { const int n = rho >> 4, i = rho & 15; return 8 * (i >> 2) + 4 * n + (i & 3); }

__device__ __forceinline__ int lane_id() { int x; asm volatile("v_mbcnt_lo_u32_b32 %0, -1, 0\n\tv_mbcnt_hi_u32_b32 %0, -1, %0" : "=v"(x)); return x; }

struct Unit { int pm, pn, hm; };
struct Gemm { const bf16_t* A; const bf16_t* Bt; int M, N, K; };

struct StaticOrder {
    static constexpr bool HALF_UNITS = false;
    int nM, nN, nwg, G, c;
    __host__ __device__ void init(int M, int N, int G_, int c_) { nM = M / BM; nN = N / BM; nwg = nM * nN; G = G_; c = c_; }
    __host__ __device__ void map(int L, Unit& u) const {
        int wgid = L; { const int q = nwg / NXCD, r = nwg % NXCD, xcd = wgid % NXCD, off = wgid / NXCD; wgid = (xcd < r ? xcd * (q + 1) : r * (q + 1) + (xcd - r) * q) + off; }
        const int nig = WGM * nN, gid = wgid / nig, fm = gid * WGM, gsz = (nM - fm) < WGM ? (nM - fm) : WGM;
        u.pm = fm + ((wgid % nig) % gsz); u.pn = (wgid % nig) / gsz; u.hm = 0;
    }
    __host__ __device__ bool next(int i, Unit& u) const {
        const long L = (long)i * G + c; if (L >= nwg) return false;
        map((int)L, u); return true;
    }
    __device__ __forceinline__ void a_ready(const Unit&) const {}
    __device__ __forceinline__ void done(const Unit&) const {}
};
struct PanelOrder {
    static constexpr bool HALF_UNITS = false;
    int j0, nj, G, c;
    __host__ __device__ bool next(int i, Unit& u) const {
        const long L = (long)i * G + c; if (L >= 64L * nj) return false;
        const int idx = (int)L, q = idx >> 3; u.pn = idx & 7; u.pm = 16 * (q / nj) + j0 + (q % nj); u.hm = 0; return true;
    }
    __device__ __forceinline__ void a_ready(const Unit&) const {}
    __device__ __forceinline__ void done(const Unit&) const {}
};
struct RowTileOrder {
    static constexpr bool HALF_UNITS = false;
    int pm, pn0, n;
    __device__ __forceinline__ bool next(int i, Unit& u) const { if (i >= n) return false; int p = pm; asm volatile("" : "+s"(p)); u.pm = p; u.pn = pn0 + i; u.hm = 0; return true; }
    __device__ __forceinline__ void a_ready(const Unit&) const {}
    __device__ __forceinline__ void done(const Unit&) const {}
};
struct TailSplitOrder : StaticOrder {
    static constexpr bool HALF_UNITS = true;
    __host__ __device__ bool next(int i, Unit& u) const {
        const int nfull = (nwg / G) * G, nhalf = 2 * (nwg - nfull);
        if (nhalf == G && (c & 1)) {
            if (i == 0) { map(nfull + (c >> 1), u); u.hm = 1 + (c & 1); return true; }
            const long L = (long)(i - 1) * G + c; if (L >= nfull) return false;
            map((int)L, u); return true;
        }
        const long L = (long)i * G + c;
        if (L < nfull) { map((int)L, u); return true; }
        const long hidx = L - nfull; if (hidx >= nhalf) return false;
        map(nfull + (int)(hidx >> 1), u); u.hm = 1 + (int)(hidx & 1); return true;
    }
};

typedef __bf16 bf16x2_t __attribute__((ext_vector_type(2)));
typedef float f32x2_t __attribute__((ext_vector_type(2)));
__device__ __forceinline__ unsigned cvt_pk_bf16(float lo, float hi) { const f32x2_t v = {lo, hi}; return __builtin_bit_cast(unsigned, __builtin_convertvector(v, bf16x2_t)); }
constexpr float RMS_EPS_F = 1e-6f;
typedef unsigned long long ssq_t;
constexpr float SSQ_SCALE = 16777216.0f;
__device__ __forceinline__ ssq_t ssq_fix(float s) { return (ssq_t)(s * SSQ_SCALE); }
__device__ __forceinline__ float rstd_of(const ssq_t* ss, int row) {
    const ssq_t q = __hip_atomic_load(ss + row, __ATOMIC_RELAXED, __HIP_MEMORY_SCOPE_AGENT);
    return __builtin_amdgcn_rsqf((float)q * (1.0f / (SSQ_SCALE * 2048.0f)) + RMS_EPS_F);
}

__device__ __forceinline__ void rstd8(const ssq_t* ss, int row0, int nai, float (&rs)[2][4]) {
    ssq_t q[2][4];
#pragma unroll
    for (int ai = 0; ai < 2; ++ai)
#pragma unroll
        for (int m = 0; m < 4; ++m) q[ai][m] = (ai < nai) ? __hip_atomic_load(ss + row0 + ai * HALF + m * 16, __ATOMIC_RELAXED, __HIP_MEMORY_SCOPE_AGENT) : (ssq_t)0;
#pragma unroll
    for (int ai = 0; ai < 2; ++ai)
#pragma unroll
        for (int m = 0; m < 4; ++m) rs[ai][m] = __builtin_amdgcn_rsqf((float)q[ai][m] * (1.0f / (SSQ_SCALE * 2048.0f)) + RMS_EPS_F);
}

struct RstdCache {
    const ssq_t* ss; PG8_LAS float* slot; mutable int key;
    __device__ __forceinline__ void get(const Unit& u, int wr, int fr, int fq, int nai, float (&rs)[2][4]) const {
        const int k = u.pm * 4 + u.hm;
        if (k != key) {
            key = k;
            const int lane = fq * 16 + fr, rbase = u.pm * BM + (u.hm == 2 ? HALF : 0) + wr * 64;
            ssq_t q[2];
#pragma unroll
            for (int e = 0; e < 2; ++e) { const int idx = lane + 64 * e, f = idx >> 3, ai = (idx >> 2) & 1, m = idx & 3;
                q[e] = (ai < nai) ? __hip_atomic_load(ss + rbase + ai * HALF + m * 16 + f, __ATOMIC_RELAXED, __HIP_MEMORY_SCOPE_AGENT) : (ssq_t)0; }
#pragma unroll
            for (int e = 0; e < 2; ++e) slot[lane + 64 * e] = __builtin_amdgcn_rsqf((float)q[e] * (1.0f / (SSQ_SCALE * 2048.0f)) + RMS_EPS_F);
            asm volatile("" ::: "memory");
        }
        const f32x4 a = *(const PG8_LAS f32x4*)(slot + fr * 8), b = *(const PG8_LAS f32x4*)(slot + fr * 8 + 4);
        rs[0][0] = a[0]; rs[0][1] = a[1]; rs[0][2] = a[2]; rs[0][3] = a[3]; rs[1][0] = b[0]; rs[1][1] = b[1]; rs[1][2] = b[2]; rs[1][3] = b[3];
    }
};

struct EpiSwiGLU {
    static constexpr bool PERM = true, AFTER_DRAIN = false;
    static constexpr int NVM_FULL = 8, NVM_HALF = 4;
    bf16_t* O; int ldc; RstdCache rc;
    __device__ __forceinline__ void operator()(const f32x4 (&acc)[2][2][4][2], const Unit& u, int wr, int wc, int fr_, int fq_) const {
        (void)fr_; (void)fq_;
        int lane_ = lane_id(); asm volatile("" : "+v"(lane_)); const int fr = lane_ & 15, fq = lane_ >> 4;
        const int nai = (u.hm == 0) ? 2 : 1;
        const int row0 = u.pm * BM + (u.hm == 2 ? HALF : 0) + wr * 64 + fr, col0 = u.pn * HALF + wc * 32 + 8 * fq;
        float rsv[2][4]; rc.get(u, wr, fr, fq, nai, rsv);
#pragma unroll
        for (int ai = 0; ai < 2; ++ai)
#pragma unroll
            for (int m = 0; m < 4; ++m) if (ai < nai) {
                const int row = row0 + ai * HALF + m * 16;
                const float rs = rsv[ai][m], rsl = rs * -1.4426950408889634f, rs2 = rs * rs;
                float a[8];
#pragma unroll
                for (int n = 0; n < 2; ++n)
#pragma unroll
                    for (int j = 0; j < 4; j += 2) {
                        const f32x2_t ag = {acc[ai][0][m][n][j], acc[ai][0][m][n][j + 1]}, au = {acc[ai][1][m][n][j], acc[ai][1][m][n][j + 1]};
                        const f32x2_t x = ag * rsl;
                        const f32x2_t e = {__builtin_amdgcn_exp2f(x[0]), __builtin_amdgcn_exp2f(x[1])};
                        const f32x2_t d = e + 1.0f;
                        const f32x2_t r = {__builtin_amdgcn_rcpf(d[0]), __builtin_amdgcn_rcpf(d[1])};
                        const f32x2_t o = (ag * au) * (r * rs2);
                        a[n * 4 + j] = o[0]; a[n * 4 + j + 1] = o[1];
                    }
                u32x4 w; w.x = cvt_pk_bf16(a[0], a[1]); w.y = cvt_pk_bf16(a[2], a[3]); w.z = cvt_pk_bf16(a[4], a[5]); w.w = cvt_pk_bf16(a[6], a[7]);
                *(u32x4*)(O + (size_t)row * ldc + col0) = w;
            }
    }
};
struct EpiResid {
    static constexpr bool PERM = true, AFTER_DRAIN = false;
    static constexpr int NVM_FULL = 32, NVM_HALF = 32;
    bf16_t* hb; ssq_t* ss; float scale;
    __device__ __forceinline__ void operator()(const f32x4 (&acc)[2][2][4][2], const Unit& u, int wr, int wc, int fr_, int fq_) const {
        (void)fr_; (void)fq_;
        int lane_ = lane_id(); asm volatile("" : "+v"(lane_)); const int fr = lane_ & 15, fq = lane_ >> 4;
        const int row0 = u.pm * BM + wr * 64 + fr, col0 = u.pn * BM + wc * 32 + 8 * fq;
        float sall[2][4];
#pragma unroll
        for (int ai = 0; ai < 2; ++ai) {
            u32x4 b[4][2];
#pragma unroll
            for (int m = 0; m < 4; ++m)
#pragma unroll
                for (int bj = 0; bj < 2; ++bj) b[m][bj] = *(const u32x4*)(hb + (size_t)(row0 + ai * HALF + m * 16) * 2048 + col0 + bj * HALF);
#pragma unroll
            for (int m = 0; m < 4; ++m) {
                const int row = row0 + ai * HALF + m * 16;
                float s = 0.f;
#pragma unroll
                for (int bj = 0; bj < 2; ++bj) {
                    u32x4 w;
#pragma unroll
                    for (int q = 0; q < 4; ++q) {
                        const float a0 = acc[ai][bj][m][q >> 1][2 * (q & 1)], a1 = acc[ai][bj][m][q >> 1][2 * (q & 1) + 1];
                        const float v0 = __uint_as_float(b[m][bj][q] << 16) + a0 * scale, v1 = __uint_as_float(b[m][bj][q] & 0xffff0000u) + a1 * scale;
                        const unsigned pk = cvt_pk_bf16(v0, v1); w[q] = pk;
                        const float r0 = __uint_as_float(pk << 16), r1 = __uint_as_float(pk & 0xffff0000u);
                        s += r0 * r0 + r1 * r1;
                    }
                    *(u32x4*)(hb + (size_t)row * 2048 + col0 + bj * HALF) = w;
                }
                sall[ai][m] = s;
            }
        }
        float t1[2][4];
        const int px16 = (lane_ ^ 16) << 2, px32 = (lane_ ^ 32) << 2;
#pragma unroll
        for (int ai = 0; ai < 2; ++ai)
#pragma unroll
            for (int m = 0; m < 4; ++m) t1[ai][m] = __builtin_bit_cast(float, __builtin_amdgcn_ds_bpermute(px16, __builtin_bit_cast(int, sall[ai][m])));
#pragma unroll
        for (int ai = 0; ai < 2; ++ai)
#pragma unroll
            for (int m = 0; m < 4; ++m) sall[ai][m] += t1[ai][m];
#pragma unroll
        for (int ai = 0; ai < 2; ++ai)
#pragma unroll
            for (int m = 0; m < 4; ++m) t1[ai][m] = __builtin_bit_cast(float, __builtin_amdgcn_ds_bpermute(px32, __builtin_bit_cast(int, sall[ai][m])));
        if (fq == 0) {
#pragma unroll
            for (int ai = 0; ai < 2; ++ai)
#pragma unroll
                for (int m = 0; m < 4; ++m) atomicAdd(ss + row0 + ai * HALF + m * 16, ssq_fix(sall[ai][m] + t1[ai][m]));
        }
    }
};
struct EpiBf16S {
    static constexpr bool PERM = true, AFTER_DRAIN = false;
    static constexpr int NVM_FULL = 16, NVM_HALF = 8;
    bf16_t* O; int ldc; RstdCache rc;
    __device__ __forceinline__ void operator()(const f32x4 (&acc)[2][2][4][2], const Unit& u, int wr, int wc, int fr_, int fq_) const {
        (void)fr_; (void)fq_;
        int lane_ = lane_id(); asm volatile("" : "+v"(lane_)); const int fr = lane_ & 15, fq = lane_ >> 4;
        const int nai = (u.hm == 0) ? 2 : 1;
        const int row0 = u.pm * BM + (u.hm == 2 ? HALF : 0) + wr * 64 + fr, col0 = u.pn * BM + wc * 32 + 8 * fq;
        float rsv[2][4]; rc.get(u, wr, fr, fq, nai, rsv);
#pragma unroll
        for (int ai = 0; ai < 2; ++ai)
#pragma unroll
            for (int m = 0; m < 4; ++m) if (ai < nai) {
                const int row = row0 + ai * HALF + m * 16;
                const float rs = rsv[ai][m];
                bf16_t* rowp = O + (size_t)row * ldc + col0;
#pragma unroll
                for (int bj = 0; bj < 2; ++bj) {
                    const f32x4 v0 = acc[ai][bj][m][0] * rs, v1 = acc[ai][bj][m][1] * rs;
                    u32x4 w; w.x = cvt_pk_bf16(v0[0], v0[1]); w.y = cvt_pk_bf16(v0[2], v0[3]); w.z = cvt_pk_bf16(v1[0], v1[1]); w.w = cvt_pk_bf16(v1[2], v1[3]);
                    *(u32x4*)(rowp + bj * HALF) = w;
                }
            }
    }
};

template <class Epi, class Sched, bool ALIGN_EPI = false, bool SP2 = false>
__device__ __forceinline__ void gemm_phase(PG8_LAS unsigned char* lds, const Gemm g, const Sched& S, const Epi& E, const int wid  ) {
    int lane_ = lane_id(); asm volatile("" : "+v"(lane_));
    const int lane = lane_, tid = wid * 64 + lane, wr = wid >> 2, wc = wid & 3, fr = lane & 15, fq = lane >> 4;
    const int K = g.K, nt = K / BK;
    unsigned voffA[2], voffB[2];
#pragma unroll
    for (int i = 0; i < 2; ++i) { int R, C; stage_rc(tid * 16 + i * 8192, R, C); const int Rb = Epi::PERM ? ((R & ~31) + perm32(R & 31)) : R;
        voffA[i] = (unsigned)(R * K + C) * 2u; voffB[i] = (unsigned)(Rb * K + C) * 2u; }
    const unsigned kstep = (unsigned)(BK * 2);
    const unsigned hstep = (unsigned)HALF * (unsigned)K * 2u;
    const unsigned tstep = 2u * hstep;
    const __amdgpu_buffer_rsrc_t rsA = __builtin_amdgcn_make_buffer_rsrc((void*)g.A, (short)0, 0x7ffffff0, 0x00020000), rsB = __builtin_amdgcn_make_buffer_rsrc((void*)g.Bt, (short)0, 0x7ffffff0, 0x00020000);
    const unsigned ldsw = (unsigned)wid * 1024u;
    const int aoff = lds_byte(wr * 64 + fr, fq * 8), boff = lds_byte(wc * 32 + fr, fq * 8);
#define PG8_SA(b, h) (((b) * 2 + (h)) * HTB)
#define PG8_SB(b, h) ((4 + (b) * 2 + (h)) * HTB)
#define PG8_STAGE(bufoff, rs, soff, voff) do { _Pragma("unroll") for (int _i = 0; _i < 2; ++_i) \
        __builtin_amdgcn_raw_ptr_buffer_load_lds((rs), (PG8_LAS void*)(lds + (bufoff) + ldsw + _i * 8192), 16, (int)(voff)[_i], (int)(soff), 0, 0); } while (0)
#define PG8_LDA(dst, b, h) do { _Pragma("unroll") for (int m = 0; m < 4; ++m) _Pragma("unroll") for (int k = 0; k < 2; ++k) dst[m][k] = *(const PG8_LAS bf16x8*)(lds + PG8_SA(b, h) + aoff + m * 2048 + k * 1024); } while (0)
#define PG8_LDB(dst, b, h) do { _Pragma("unroll") for (int n = 0; n < 2; ++n) _Pragma("unroll") for (int k = 0; k < 2; ++k) dst[n][k] = *(const PG8_LAS bf16x8*)(lds + PG8_SB(b, h) + boff + n * 2048 + k * 1024); } while (0)
#define PG8_P1(bufoff, rs, soff, voff, i) __builtin_amdgcn_raw_ptr_buffer_load_lds((rs), (PG8_LAS void*)(lds + (bufoff) + ldsw + (i) * 8192), 16, (int)(voff)[i], (int)(soff), 0, 0)
#define PG8_LDA1(dst, b, h, m) do { _Pragma("unroll") for (int k = 0; k < 2; ++k) dst[m][k] = *(const PG8_LAS bf16x8*)(lds + PG8_SA(b, h) + aoff + (m) * 2048 + k * 1024); } while (0)
#define PG8_MMA(ai, bj, At, Bt) do { __builtin_amdgcn_s_setprio(1); _Pragma("unroll") for (int m = 0; m < 4; ++m) _Pragma("unroll") for (int n = 0; n < 2; ++n) _Pragma("unroll") for (int k = 0; k < 2; ++k) \
        acc[ai][bj][m][n] = __builtin_amdgcn_mfma_f32_16x16x32_bf16(Bt[n][k], At[m][k], acc[ai][bj][m][n], 0, 0, 0); __builtin_amdgcn_s_setprio(0); } while (0)
#define PG8_WAIT_V(n) asm volatile("s_waitcnt vmcnt(" #n ")" ::: "memory")
#define PG8_WAIT_L(n) asm volatile("s_waitcnt lgkmcnt(" #n ")" ::: "memory")
#define PG8_WAIT_VN(n) asm volatile("s_waitcnt vmcnt(%0)" :: "n"(n) : "memory")
#define PG8_BAR __builtin_amdgcn_s_barrier()
#define PG8_SCHED __builtin_amdgcn_sched_barrier(0)
#define PG8_TRIP(W1, W2) do { \
            PG8_LDB(B0, 0, 0); PG8_P1(PG8_SA(1, 1), rsA, a1 + hstep, voffA, 0); PG8_LDB(B1, 0, 1); PG8_P1(PG8_SA(1, 1), rsA, a1 + hstep, voffA, 1); PG8_SCHED; PG8_LDA(At, 0, 0); \
            W1; PG8_WAIT_L(0); PG8_BAR; PG8_MMA(0, 0, At, B0); PG8_MMA(0, 1, At, B1); PG8_BAR; PG8_SCHED; \
            PG8_P1(PG8_SB(0, 0), rsB, b2, voffB, 0); PG8_LDA1(At, 0, 1, 0); PG8_P1(PG8_SB(0, 0), rsB, b2, voffB, 1); PG8_LDA1(At, 0, 1, 1); PG8_P1(PG8_SB(0, 1), rsB, b2 + hstep, voffB, 0); PG8_LDA1(At, 0, 1, 2); PG8_P1(PG8_SB(0, 1), rsB, b2 + hstep, voffB, 1); PG8_LDA1(At, 0, 1, 3); PG8_P1(PG8_SA(0, 0), rsA, a2, voffA, 0); PG8_P1(PG8_SA(0, 0), rsA, a2, voffA, 1); \
            W2; PG8_WAIT_L(0); PG8_BAR; if (cur.hm == 0) { PG8_MMA(1, 0, At, B0); PG8_MMA(1, 1, At, B1); } PG8_BAR; PG8_SCHED; \
            PG8_LDB(B0, 1, 0); PG8_P1(PG8_SA(0, 1), rsA, a2 + hstep, voffA, 0); PG8_LDB(B1, 1, 1); PG8_P1(PG8_SA(0, 1), rsA, a2 + hstep, voffA, 1); PG8_SCHED; PG8_LDA(At, 1, 0); \
            PG8_WAIT_V(8); PG8_WAIT_L(0); PG8_BAR; PG8_MMA(0, 0, At, B0); PG8_MMA(0, 1, At, B1); PG8_BAR; PG8_SCHED; \
            PG8_P1(PG8_SB(1, 0), rsB, b3, voffB, 0); PG8_LDA1(At, 1, 1, 0); PG8_P1(PG8_SB(1, 0), rsB, b3, voffB, 1); PG8_LDA1(At, 1, 1, 1); PG8_P1(PG8_SB(1, 1), rsB, b3 + hstep, voffB, 0); PG8_LDA1(At, 1, 1, 2); PG8_P1(PG8_SB(1, 1), rsB, b3 + hstep, voffB, 1); PG8_LDA1(At, 1, 1, 3); PG8_P1(PG8_SA(1, 0), rsA, a3, voffA, 0); PG8_P1(PG8_SA(1, 0), rsA, a3, voffA, 1); \
            PG8_WAIT_V(8); PG8_WAIT_L(0); PG8_BAR; if (cur.hm == 0) { PG8_MMA(1, 0, At, B0); PG8_MMA(1, 1, At, B1); } PG8_BAR; PG8_SCHED; \
            } while (0)
    Unit cur, nxt; int ui = 0;
    if (!S.next(0, cur)) return;
    f32x4 acc[2][2][4][2];
#pragma unroll
    for (int a = 0; a < 2; ++a)
#pragma unroll
        for (int b = 0; b < 2; ++b)
#pragma unroll
            for (int m = 0; m < 4; ++m)
#pragma unroll
                for (int n = 0; n < 2; ++n) acc[a][b][m][n] = (f32x4){0.f, 0.f, 0.f, 0.f};
    bf16x8 At[4][2], B0[2][2], B1[2][2];
    unsigned cA = (unsigned)cur.pm * tstep + (cur.hm == 2 ? hstep : 0u), cB = (unsigned)cur.pn * tstep;
    S.a_ready(cur);
    if constexpr (SP2) {
        PG8_STAGE(PG8_SB(0, 0), rsB, cB, voffB); PG8_STAGE(PG8_SB(0, 1), rsB, cB + hstep, voffB); PG8_STAGE(PG8_SA(0, 0), rsA, cA, voffA); PG8_STAGE(PG8_SA(0, 1), rsA, cA + hstep, voffA);
        PG8_STAGE(PG8_SB(1, 0), rsB, cB + kstep, voffB); PG8_STAGE(PG8_SA(1, 0), rsA, cA + kstep, voffA); PG8_STAGE(PG8_SB(1, 1), rsB, cB + hstep + kstep, voffB);
        if (wr == 1) PG8_BAR;
        PG8_WAIT_V(0); PG8_BAR;
        PG8_BAR;
    } else {
        PG8_STAGE(PG8_SB(0, 0), rsB, cB, voffB); PG8_STAGE(PG8_SA(0, 0), rsA, cA, voffA); PG8_STAGE(PG8_SB(0, 1), rsB, cB + hstep, voffB); PG8_STAGE(PG8_SA(0, 1), rsA, cA + hstep, voffA);
        if (wr == 1) PG8_BAR;
        PG8_WAIT_V(4); PG8_BAR;
        PG8_STAGE(PG8_SB(1, 0), rsB, cB + kstep, voffB); PG8_STAGE(PG8_SA(1, 0), rsA, cA + kstep, voffA); PG8_STAGE(PG8_SB(1, 1), rsB, cB + hstep + kstep, voffB);
        PG8_WAIT_V(6); PG8_BAR;
    }
    for (;;) {
        const bool has_next = S.next(ui + 1, nxt);
        const unsigned nA = has_next ? (unsigned)nxt.pm * tstep + (nxt.hm == 2 ? hstep : 0u) : cA, nB = has_next ? (unsigned)nxt.pn * tstep : cB;
        int t0 = 0;
        if constexpr (SP2) {
            constexpr int NVM = Sched::HALF_UNITS ? Epi::NVM_HALF : Epi::NVM_FULL;
            const unsigned a1 = cA + kstep, a2 = cA + 2 * kstep, b2 = cB + 2 * kstep, a3 = a2 + kstep, b3 = b2 + kstep;
            PG8_TRIP(PG8_WAIT_VN(8 + NVM), PG8_WAIT_VN(8 + NVM));
            t0 = 2;
        }
        for (int t = t0; t < nt; t += 2) {
            const bool last = (t == nt - 2);
            const unsigned a1 = cA + (unsigned)(t + 1) * kstep;
            const unsigned a2 = last ? nA : cA + (unsigned)(t + 2) * kstep, b2 = last ? nB : cB + (unsigned)(t + 2) * kstep;
            const unsigned a3 = a2 + kstep, b3 = b2 + kstep;
            if (last && has_next) S.a_ready(nxt);
            if constexpr (SP2) {
            PG8_TRIP(PG8_WAIT_V(8), PG8_WAIT_V(8));
            } else {
            PG8_LDB(B0, 0, 0); PG8_SCHED; PG8_LDA(At, 0, 0); PG8_STAGE(PG8_SA(1, 1), rsA, a1 + hstep, voffA);
            PG8_WAIT_L(8); PG8_BAR; PG8_WAIT_L(0); PG8_MMA(0, 0, At, B0); PG8_BAR; PG8_SCHED;
            PG8_LDB(B1, 0, 1); PG8_STAGE(PG8_SB(0, 0), rsB, b2, voffB);
            PG8_BAR; PG8_WAIT_L(0); PG8_MMA(0, 1, At, B1); PG8_BAR;
            PG8_LDA(At, 0, 1); PG8_STAGE(PG8_SA(0, 0), rsA, a2, voffA);
            PG8_BAR; PG8_WAIT_L(0); if (cur.hm == 0) PG8_MMA(1, 0, At, B0); PG8_BAR; PG8_SCHED;
            PG8_STAGE(PG8_SB(0, 1), rsB, b2 + hstep, voffB);
            PG8_WAIT_V(6); PG8_BAR; if (cur.hm == 0) PG8_MMA(1, 1, At, B1); PG8_BAR;
            PG8_LDB(B0, 1, 0); PG8_SCHED; PG8_LDA(At, 1, 0); PG8_STAGE(PG8_SA(0, 1), rsA, a2 + hstep, voffA);
            PG8_WAIT_L(8); PG8_BAR; PG8_WAIT_L(0); PG8_MMA(0, 0, At, B0); PG8_BAR; PG8_SCHED;
            PG8_LDB(B1, 1, 1); PG8_STAGE(PG8_SB(1, 0), rsB, b3, voffB);
            PG8_BAR; PG8_WAIT_L(0); PG8_MMA(0, 1, At, B1); PG8_BAR;
            PG8_LDA(At, 1, 1); PG8_STAGE(PG8_SA(1, 0), rsA, a3, voffA);
            PG8_BAR; PG8_WAIT_L(0); if (cur.hm == 0) PG8_MMA(1, 0, At, B0); PG8_BAR; PG8_SCHED;
            PG8_STAGE(PG8_SB(1, 1), rsB, b3 + hstep, voffB);
            PG8_WAIT_V(6); PG8_BAR; if (cur.hm == 0) PG8_MMA(1, 1, At, B1); PG8_BAR;
            }
        }
        if constexpr (ALIGN_EPI) { if (wr == 0) PG8_BAR; }
        if constexpr (!Epi::AFTER_DRAIN) { E(acc, cur, wr, wc, fr, fq); S.done(cur); }
        if (!has_next) break;
#pragma unroll
        for (int a = 0; a < 2; ++a)
#pragma unroll
            for (int b = 0; b < 2; ++b)
#pragma unroll
                for (int m = 0; m < 4; ++m)
#pragma unroll
                    for (int n = 0; n < 2; ++n) acc[a][b][m][n] = (f32x4){0.f, 0.f, 0.f, 0.f};
        cur = nxt; cA = nA; cB = nB; ++ui;
        if constexpr (ALIGN_EPI) { if (wr == 1) PG8_BAR; }
    }
    PG8_WAIT_V(0);
    if constexpr (!ALIGN_EPI) { if (wr == 0) PG8_BAR; }
    PG8_BAR;
    if constexpr (Epi::AFTER_DRAIN) { E.fused(acc, cur, wr, wc, fr, fq, lds, wid, lane); S.done(cur); }
#undef PG8_SA
#undef PG8_SB
#undef PG8_STAGE
#undef PG8_LDA
#undef PG8_LDB
#undef PG8_MMA
#undef PG8_WAIT_V
#undef PG8_WAIT_L
#undef PG8_WAIT_VN
#undef PG8_TRIP
#undef PG8_P1
#undef PG8_LDA1
#undef PG8_BAR
#undef PG8_SCHED
}
}

constexpr int NWAVES = 8;
constexpr int D = 2048, BATCH = 8, T = 4096, M = BATCH * T, DEPTH = 4;
constexpr int RW = 1024;
constexpr int PW = 6912, FF = 5504, LRK = 256, LRN = 3072;
constexpr int P_LR = 3072;
constexpr int P_CONV = 3328, P_HG = 4864;
constexpr int Y_CONV = 1024, Y_HG = 1536;
constexpr int NPH = 2 + DEPTH * 8;

constexpr size_t MiB = 1u << 20;
constexpr size_t WS_CTL = 0, WS_SS = 1 * MiB, ZERO_BYTES = 5 * MiB;
constexpr size_t W_GU1 = 8 * MiB, W_D1 = W_GU1 + (size_t)2 * FF * D * 2, W_IN = W_D1 + (size_t)D * FF * 2, W_LR = W_IN + (size_t)PW * D * 2,
                 W_OUT = W_LR + (size_t)LRN * LRK * 2, W_GU2 = W_OUT + (size_t)D * D * 2, W_D2 = W_GU2 + (size_t)2 * FF * D * 2, W_END = W_D2 + (size_t)D * FF * 2;
static_assert(W_END <= 176 * MiB && WS_SS + (size_t)13 * M * 8 <= ZERO_BYTES, "ws map");
constexpr size_t WS_HB = 176 * MiB;
constexpr size_t WS_PROJ = 304 * MiB;
constexpr size_t WS_ACT = 304 * MiB;
constexpr size_t WS_LRA = 736 * MiB;
constexpr size_t WS_LR = 752 * MiB;
constexpr size_t WS_Y = 944 * MiB;
constexpr size_t WS_END = 1072 * MiB;
constexpr int CW_BAR = 4096;
constexpr int RING_BYTES = 131072, MISC_OFF = 146432, PTAB_OFF = MISC_OFF + 128, LDS_BYTES = 147456;

#define GAS __attribute__((address_space(1)))
#define LAS __attribute__((address_space(3)))
typedef unsigned short bf16;
typedef unsigned v4u __attribute__((ext_vector_type(4)));
typedef unsigned v2u __attribute__((ext_vector_type(2)));
typedef float f32x4 __attribute__((ext_vector_type(4)));
#define LDS_WAIT() asm volatile("s_waitcnt lgkmcnt(0)" ::: "memory")
typedef __bf16 bf16x2_t __attribute__((ext_vector_type(2)));
typedef float f32x2_t __attribute__((ext_vector_type(2)));
__device__ __forceinline__ unsigned pk2(float lo, float hi) { const f32x2_t v = {lo, hi}; return __builtin_bit_cast(unsigned, __builtin_convertvector(v, bf16x2_t)); }
__device__ __forceinline__ unsigned f2bf(float f) { return pk2(f, f) & 0xffffu; }
__device__ __forceinline__ float bf2f(bf16 x) { return __uint_as_float(((unsigned)x) << 16); }
__device__ __forceinline__ float bflo(unsigned u) { return __uint_as_float(u << 16); }
__device__ __forceinline__ float bfhi(unsigned u) { return __uint_as_float(u & 0xffff0000u); }
__device__ __forceinline__ float sigm(float x) { return __builtin_amdgcn_rcpf(1.0f + __expf(-x)); }
template <int CTRL> __device__ __forceinline__ float dpp_mov(float v) { return __builtin_bit_cast(float, __builtin_amdgcn_update_dpp(0, __builtin_bit_cast(int, v), CTRL, 0xF, 0xF, true)); }
__device__ __forceinline__ float wave_sum(float v) {
    v += dpp_mov<0xB1>(v); v += dpp_mov<0x4E>(v); v += dpp_mov<0x141>(v); v += dpp_mov<0x140>(v);
    const int iv = __builtin_bit_cast(int, v);
    const float r0 = __builtin_bit_cast(float, __builtin_amdgcn_readlane(iv, 0)), r1 = __builtin_bit_cast(float, __builtin_amdgcn_readlane(iv, 16));
    const float r2 = __builtin_bit_cast(float, __builtin_amdgcn_readlane(iv, 32)), r3 = __builtin_bit_cast(float, __builtin_amdgcn_readlane(iv, 48));
    return (r0 + r1) + (r2 + r3);
}
__device__ __forceinline__ float dpp_f(float v, const int ctrl_sel) {
    const int x = __builtin_bit_cast(int, v);
    int r;
    if (ctrl_sel == 0) r = __builtin_amdgcn_update_dpp(0, x, 0xB1, 0xF, 0xF, true);
    else if (ctrl_sel == 1) r = __builtin_amdgcn_update_dpp(0, x, 0x4E, 0xF, 0xF, true);
    else r = __builtin_amdgcn_update_dpp(0, x, 0x141, 0xF, 0xF, true);
    return __builtin_bit_cast(float, r);
}
__device__ __forceinline__ float sum8(float v) { v += dpp_f(v, 0); v += dpp_f(v, 1); v += dpp_f(v, 2); return v; }


struct PTab {
    LAS unsigned long long* t;
    __device__ __forceinline__ const float* operator[](int i) const {
        const unsigned long long v = t[i];
        const unsigned lo = __builtin_amdgcn_readfirstlane((unsigned)v), hi = __builtin_amdgcn_readfirstlane((unsigned)(v >> 32));
        return (const float*)(const GAS float*)(((unsigned long long)hi << 32) | lo);
    }
};
#define XB_TMO      128
#define XB_XCNT(j)  (256  + 64 * (j))
#define XB_XSUB(j)  (1280 + 64 * (j))
#define XB_XGEN(j)  (2304 + 64 * (j))
#define XB_TOP      3328
#define XB_TOPGEN   3392
#define XCD_BAR_WORDS 3456
#define XB_SPIN_CAP (1u << 18)

__device__ __forceinline__ unsigned xb_ld(unsigned* p)              { return __hip_atomic_load(p, __ATOMIC_RELAXED, __HIP_MEMORY_SCOPE_AGENT); }
__device__ __forceinline__ unsigned xb_add(unsigned* p, unsigned v) { return __hip_atomic_fetch_add(p, v, __ATOMIC_RELAXED, __HIP_MEMORY_SCOPE_AGENT); }
__device__ __forceinline__ unsigned xb_xcc_id() { return (unsigned)__builtin_amdgcn_s_getreg((3 << 11) | 20) & 0xFu; }
#define XB_SPIN(cond, bar) do { unsigned _sp = 0; while (cond) { __builtin_amdgcn_s_sleep(1); \
    if ((++_sp & 255u) == 0u) { if (xb_ld(&(bar)[XB_TMO])) break; if (_sp > XB_SPIN_CAP) { atomicAdd(&(bar)[XB_TMO], 1u); break; } } } } while (0)

struct XcdBarrier {
    unsigned* bar; unsigned x;
    bool lead;
    volatile LAS unsigned* st;
};

__device__ __forceinline__ XcdBarrier xcd_barrier_post(unsigned* bar, volatile LAS unsigned* st) {
    XcdBarrier b; b.bar = bar; b.x = xb_xcc_id(); b.st = st; b.lead = (threadIdx.x == 0);
    if (b.lead) (void)xb_add(&bar[XB_XCNT(b.x)], 1u);
    return b;
}
__device__ __forceinline__ void xcd_barrier_complete(unsigned* bar, unsigned x, unsigned& nloc, unsigned& nx) {
    const unsigned G = gridDim.x * gridDim.y * gridDim.z;
    unsigned sum, cnt, mine, sp = 0u;
    for (;;) {
        sum = 0u; cnt = 0u; mine = 0u;
#pragma unroll
        for (unsigned j = 0; j < 16; ++j) { const unsigned c = xb_ld(&bar[XB_XCNT(j)]); sum += c; cnt += (c > 0u) ? 1u : 0u; mine = (j == x) ? c : mine; }
        if (sum == G) break;
        __builtin_amdgcn_s_sleep(1);
        if ((++sp & 255u) == 0u) { if (xb_ld(&bar[XB_TMO])) break; if (sp > XB_SPIN_CAP) { atomicAdd(&bar[XB_TMO], 1u); break; } }
    }
    nloc = mine > 0u ? mine : 1u; nx = cnt > 0u ? cnt : 1u;
}

__device__ __forceinline__ void xcd_barrier(const XcdBarrier& b) {
    asm volatile("s_waitcnt vmcnt(0)" ::: "memory");
    __syncthreads();
    if (b.lead) {
        unsigned* bar = b.bar;
        __builtin_amdgcn_s_waitcnt(0);
        unsigned nloc = b.st[0], nx = b.st[1];
        if (nloc == 0u) { xcd_barrier_complete(bar, b.x, nloc, nx); b.st[0] = nloc; b.st[1] = nx; }
        const unsigned old = xb_add(&bar[XB_XSUB(b.x)], 1u);
        const unsigned gen = old / nloc;
        if (old + 1u == (gen + 1u) * nloc) {
            __builtin_amdgcn_fence(__ATOMIC_RELEASE, "agent");
            asm volatile("s_waitcnt vmcnt(0)" ::: "memory");
            const unsigned og = xb_add(&bar[XB_TOP], 1u);
            const unsigned tg = og / nx;
            if (og + 1u == (tg + 1u) * nx) xb_add(&bar[XB_TOPGEN], 1u);
            else XB_SPIN(xb_ld(&bar[XB_TOPGEN]) == tg, bar);
            __builtin_amdgcn_fence(__ATOMIC_ACQUIRE, "agent");
            xb_add(&bar[XB_XGEN(b.x)], 1u);
            asm volatile("s_waitcnt vmcnt(0)" ::: "memory");
        } else {
            XB_SPIN(xb_ld(&bar[XB_XGEN(b.x)]) == gen, bar);
            __builtin_amdgcn_fence(__ATOMIC_ACQUIRE, "agent");
            asm volatile("s_waitcnt vmcnt(0)" ::: "memory");
        }
    }
    __syncthreads();
}

struct GBar { unsigned* bar; volatile LAS unsigned* st; int wv; };
__device__ __forceinline__ void grid_sync(const GBar& g) { XcdBarrier b; b.bar = g.bar; b.x = xb_xcc_id(); b.st = g.st; b.lead = (g.wv == 0) && (pg8::lane_id() == 0); xcd_barrier(b); }
constexpr int SEG_C1 = 24, SEG_C2 = 44, SEG_C3 = 54;
constexpr int SEG_J1 = 6, SEG_J2 = 9, SEG_J3 = 12;
static_assert(4 * SEG_J1 <= SEG_C1 && 4 * SEG_J2 <= SEG_C2 && 4 * SEG_J3 <= SEG_C3, "a panel's chunks are done before its W_out units start");

typedef short bf16x8 __attribute__((ext_vector_type(8)));
typedef float f32x16 __attribute__((ext_vector_type(16)));
#define LBAR() do { asm volatile("s_waitcnt lgkmcnt(0)" ::: "memory"); __builtin_amdgcn_s_barrier(); asm volatile("" ::: "memory"); } while (0)
#define MFMA32(a, b, c) __builtin_amdgcn_mfma_f32_32x32x16_bf16((a), (b), (c), 0, 0, 0)
__device__ __forceinline__ bf16x8 ldfrag(const LAS unsigned char* base, int row, int ld, int kbyte) { return *(const LAS bf16x8*)(base + row * ld + kbyte); }

__device__ __forceinline__ void hgrn_chain_mfma(LAS unsigned char* lds, PTab in, int l, int b, int hh, const bf16* proj, bf16* y, int tid, GBar gb) {
    constexpr int LD128 = 272, LD64 = 144, LDO = 132;
    constexpr int O_QH = 0, O_QM = 17408, O_KM = 34816, O_KHT = 52224, O_IT = 70656, O_ST = 89088, O_SC = 123904, O_EGL = 133120, O_PQ = 133632;
    const int lane = tid & 63, wave = __builtin_amdgcn_readfirstlane(tid >> 6);
    LAS unsigned char* Qh = lds + O_QH; LAS unsigned char* Qm = lds + O_QM; LAS unsigned char* Km = lds + O_KM; LAS unsigned char* KhT = lds + O_KHT;
    LAS unsigned char* iT = lds + O_IT; LAS unsigned char* St = lds + O_ST; LAS unsigned char* Sc = lds + O_SC;
    LAS float* eGL = (LAS float*)(lds + O_EGL); LAS float* Pq = (LAS float*)(lds + O_PQ); LAS float* Ob = (LAS float*)lds;
    const int pk0 = (wave & 1) * 64 + lane, tq = wave >> 1;
    float lb;
    {
        const float* hlb = in[18]; const int cc = hh * 128 + pk0;
        const float x0 = hlb[cc], x1 = hlb[512 + cc], x2 = hlb[1024 + cc], x3 = hlb[1536 + cc];
        const float mx = fmaxf(fmaxf(x0, x1), fmaxf(x2, x3));
        const float e0 = expf(x0 - mx), e1 = expf(x1 - mx), e2 = expf(x2 - mx), e3 = expf(x3 - mx);
        float acc = 0.f; if (l >= 1) acc += e1; if (l >= 2) acc += e2; if (l >= 3) acc += e3;
        lb = acc / (e0 + e1 + e2 + e3);
    }
    const float* hn = in[19];
    const float nw0 = hn[l * 512 + hh * 128 + lane], nw1 = hn[l * 512 + hh * 128 + 64 + lane];
    const int sti = wave >> 1, ssi = wave & 1;
    const int oti = wave >> 2, ovi = wave & 3;
    const int ki = wave >> 1, vj0 = 2 * (wave & 1);
    f32x16 S0, S1;
#pragma unroll
    for (int i = 0; i < 16; ++i) { S0[i] = 0.f; S1[i] = 0.f; }
    for (int i = tid; i < 34816 / 4; i += 512) ((LAS unsigned*)St)[i] = 0u;
    const size_t mbase = (size_t)b * T;
    const bf16* pcol = proj + P_HG + hh * 128;
    bf16 rq[16], rf[16], ri[16], rg[16];
    auto load_raw = [&](int c) {
        const bf16* p = pcol + (mbase + (size_t)c * 64 + 16 * tq) * PW + pk0;
#pragma unroll
        for (int j = 0; j < 16; ++j) { rq[j] = p[(size_t)j * PW]; rf[j] = p[(size_t)j * PW + 512]; ri[j] = p[(size_t)j * PW + 1024]; }
        const bf16* pg = pcol + 1536 + (mbase + (size_t)c * 64 + 8 * wave) * PW + lane;
#pragma unroll
        for (int j = 0; j < 8; ++j) { rg[2 * j] = pg[(size_t)j * PW]; rg[2 * j + 1] = pg[(size_t)j * PW + 64]; }
    };
    load_raw(0);
    __syncthreads();
    for (int c = 0; c < T / 64; ++c) {
        if (c == SEG_C1 || c == SEG_C2 || c == SEG_C3) grid_sync(gb);
        int ln = lane; asm volatile("" : "+v"(ln));
        const int r = ln & 31, h = ln >> 5, pk = (wave & 1) * 64 + ln;
        float cq[16], ck[16], cg[16]; unsigned ipk[8]; float og[16];
        {
            float run = 0.f;
#pragma unroll
            for (int j = 0; j < 16; ++j) {
                const float f = bf2f(rf[j]), sg = sigm(f);
                run += __logf(fmaxf(lb + (1.0f - lb) * sg, 1e-30f)); cg[j] = run;
                ck[j] = (1.0f - lb) * (1.0f - sg);
                const float qr = bf2f(rq[j]); cq[j] = qr * sigm(qr);
            }
#pragma unroll
            for (int j = 0; j < 8; ++j) ipk[j] = (unsigned)ri[2 * j] | ((unsigned)ri[2 * j + 1] << 16);
#pragma unroll
            for (int j = 0; j < 16; ++j) og[j] = bf2f(rg[j]);
            Pq[tq * 128 + pk] = run;
        }
        LBAR();
        {
            const float p0 = Pq[pk], p1 = Pq[128 + pk], p2 = Pq[256 + pk], p3 = Pq[384 + pk];
            const float pre = (tq > 0 ? p0 : 0.f) + (tq > 1 ? p1 : 0.f) + (tq > 2 ? p2 : 0.f), GL = (p0 + p1) + (p2 + p3), Gmid = p0 + p1;
            unsigned kh[8];
#pragma unroll
            for (int j = 0; j < 16; j += 2) {
                float khv[2];
#pragma unroll
                for (int e = 0; e < 2; ++e) {
                    const int t = 16 * tq + j + e; const float G = pre + cg[j + e];
                    *(LAS bf16*)(Qh + t * LD128 + 2 * pk) = (bf16)f2bf(cq[j + e] * __expf(G));
                    *(LAS bf16*)(Qm + t * LD128 + 2 * pk) = (bf16)f2bf(cq[j + e] * __expf(fminf(G - Gmid, 80.f)));
                    *(LAS bf16*)(Km + t * LD128 + 2 * pk) = (bf16)f2bf(ck[j + e] * __expf(fminf(Gmid - G, 80.f)));
                    khv[e] = ck[j + e] * __expf(GL - G);
                }
                kh[j >> 1] = pk2(khv[0], khv[1]);
            }
            *(LAS v4u*)(KhT + pk * LD64 + 32 * tq) = (v4u){kh[0], kh[1], kh[2], kh[3]};
            *(LAS v4u*)(KhT + pk * LD64 + 32 * tq + 16) = (v4u){kh[4], kh[5], kh[6], kh[7]};
            *(LAS v4u*)(iT + pk * LD64 + 32 * tq) = (v4u){ipk[0], ipk[1], ipk[2], ipk[3]};
            *(LAS v4u*)(iT + pk * LD64 + 32 * tq + 16) = (v4u){ipk[4], ipk[5], ipk[6], ipk[7]};
            if (tq == 0) eGL[pk] = __expf(GL);
        }
        LBAR();
        if (c + 1 < T / 64) load_raw(c + 1);
        auto s_update = [&]() {
#pragma unroll
            for (int g = 0; g < 4; ++g) { const f32x4 e = *(const LAS f32x4*)(eGL + 32 * ki + 8 * g + 4 * h);
#pragma unroll
                for (int q = 0; q < 4; ++q) { S0[4 * g + q] *= e[q]; S1[4 * g + q] *= e[q]; } }
#pragma unroll
            for (int ks = 0; ks < 4; ++ks) {
                const bf16x8 a = ldfrag(KhT, 32 * ki + r, LD64, 32 * ks + 16 * h);
                const bf16x8 b0 = ldfrag(iT, 32 * vj0 + r, LD64, 32 * ks + 16 * h), b1 = ldfrag(iT, 32 * (vj0 + 1) + r, LD64, 32 * ks + 16 * h);
                S0 = MFMA32(a, b0, S0); S1 = MFMA32(a, b1, S1);
            }
        };
        if (wave < 4) {
            f32x16 sc;
#pragma unroll
            for (int i = 0; i < 16; ++i) sc[i] = 0.f;
#pragma unroll
            for (int ks = 0; ks < 8; ++ks) sc = MFMA32(ldfrag(Qm, 32 * sti + r, LD128, 32 * ks + 16 * h), ldfrag(Km, 32 * ssi + r, LD128, 32 * ks + 16 * h), sc);
            const int s = 32 * ssi + r;
#pragma unroll
            for (int i = 0; i < 16; ++i) { const int t = 32 * sti + (i & 3) + 8 * (i >> 2) + 4 * h;
                *(LAS bf16*)(Sc + t * LD64 + 2 * s) = (bf16)f2bf(s <= t ? sc[i] : 0.f); }
        } else s_update();
        LBAR();
        f32x16 oa;
#pragma unroll
        for (int i = 0; i < 16; ++i) oa[i] = 0.f;
#pragma unroll
        for (int ks = 0; ks < 8; ++ks) oa = MFMA32(ldfrag(Qh, 32 * oti + r, LD128, 32 * ks + 16 * h), ldfrag(St, 32 * ovi + r, LD128, 32 * ks + 16 * h), oa);
#pragma unroll
        for (int ks = 0; ks < 4; ++ks) oa = MFMA32(ldfrag(Sc, 32 * oti + r, LD64, 32 * ks + 16 * h), ldfrag(iT, 32 * ovi + r, LD64, 32 * ks + 16 * h), oa);
        if (wave < 4) s_update();
        LBAR();
#pragma unroll
        for (int i = 0; i < 16; ++i) Ob[(32 * oti + (i & 3) + 8 * (i >> 2) + 4 * h) * LDO + 32 * ovi + r] = oa[i];
#pragma unroll
        for (int g = 0; g < 4; ++g) {
            const int k0 = 32 * ki + 8 * g + 4 * h;
            *(LAS v2u*)(St + (32 * vj0 + r) * LD128 + 2 * k0) = (v2u){pk2(S0[4 * g], S0[4 * g + 1]), pk2(S0[4 * g + 2], S0[4 * g + 3])};
            *(LAS v2u*)(St + (32 * (vj0 + 1) + r) * LD128 + 2 * k0) = (v2u){pk2(S1[4 * g], S1[4 * g + 1]), pk2(S1[4 * g + 2], S1[4 * g + 3])};
        }
        LBAR();
#pragma unroll
        for (int j = 0; j < 8; ++j) {
            const int t = 8 * wave + j;
            const float o0 = Ob[t * LDO + ln], o1 = Ob[t * LDO + 64 + ln];
            const float rs = __builtin_amdgcn_rsqf(wave_sum(o0 * o0 + o1 * o1) * (1.0f / 128.0f) + 1e-5f);
            const float g0 = og[2 * j], g1 = og[2 * j + 1];
            bf16* yo = y + (mbase + (size_t)c * 64 + t) * D + Y_HG + hh * 128;
            yo[ln] = (bf16)f2bf(o0 * rs * nw0 * (g0 * sigm(g0)));
            yo[64 + ln] = (bf16)f2bf(o1 * rs * nw1 * (g1 * sigm(g1)));
        }
        LBAR();
    }
}

__device__ __forceinline__ void wave_sum8(LAS float* scr, int ln, const float (&v)[8], float (&tot)[8]) {
#pragma unroll
    for (int q = 0; q < 8; ++q) scr[q * 64 + ln] = v[q];
    asm volatile("" ::: "memory");
    const LAS float* src = scr + (ln >> 3) * 64 + (ln & 7) * 8;
    const f32x4 a = *(const LAS f32x4*)src, b = *(const LAS f32x4*)(src + 4);
    float s = ((a[0] + a[1]) + (a[2] + a[3])) + ((b[0] + b[1]) + (b[2] + b[3]));
    s += dpp_mov<0xB1>(s); s += dpp_mov<0x4E>(s); s += dpp_mov<0x141>(s);
#pragma unroll
    for (int q = 0; q < 8; ++q) tot[q] = __builtin_bit_cast(float, __builtin_amdgcn_readlane(__builtin_bit_cast(int, s), 8 * q));
    asm volatile("" ::: "memory");
}
#define MFMA16(a, b, c) __builtin_amdgcn_mfma_f32_16x16x32_bf16((a), (b), (c), 0, 0, 0)
__device__ __forceinline__ void rwkv_chain_mfma(LAS unsigned char* lds, PTab in, int l, int b, int hh, const bf16* proj, const bf16* lr, bf16* y, int tid, GBar gb) {
    constexpr int LD = 144, ASZ = 64 * LD, LDF = 68;
    constexpr int O_A = 0, O_R = ASZ, O_BT = 2 * ASZ, O_KT = 3 * ASZ, O_VT = 4 * ASZ, O_ST = 5 * ASZ, O_MK = 6 * ASZ, O_NB = 7 * ASZ, O_NK = 8 * ASZ, O_TT = 9 * ASZ, O_TTT = 10 * ASZ;
    constexpr int O_B = 11 * ASZ, O_K = 12 * ASZ, O_WT = O_B, O_UT = O_K, O_MF = 13 * ASZ, O_GL = O_MF + 64 * LDF * 4, O_PW = O_GL + 256, O_BON = O_PW + 2048, O_PT = O_BON + 256, O_END = O_PT + 3 * 16 * 48;
    static_assert(O_END <= MISC_OFF, "rwkv LDS map");
    const int lane = tid & 63, wave = __builtin_amdgcn_readfirstlane(tid >> 6);
    LAS unsigned char* A_ = lds + O_A; LAS unsigned char* R_ = lds + O_R; LAS unsigned char* BT = lds + O_BT; LAS unsigned char* KT = lds + O_KT; LAS unsigned char* VT = lds + O_VT;
    LAS unsigned char* ST = lds + O_ST; LAS unsigned char* MK = lds + O_MK; LAS unsigned char* NB = lds + O_NB; LAS unsigned char* NK = lds + O_NK; LAS unsigned char* TT = lds + O_TT;
    LAS unsigned char* TTt = lds + O_TTT; LAS unsigned char* B_ = lds + O_B; LAS unsigned char* K_ = lds + O_K; LAS unsigned char* WT = lds + O_WT; LAS unsigned char* UT = lds + O_UT;
    LAS float* MF = (LAS float*)(lds + O_MF); LAS float* GLs = (LAS float*)(lds + O_GL); LAS float* Pw = (LAS float*)(lds + O_PW); LAS float* Bon = (LAS float*)(lds + O_BON);
    LAS unsigned char* Pt = lds + O_PT;
    const int ch = hh * 64 + lane;
    const float* mu = in[6] + l * 3328;
    const float mu_r = mu[ch], mu_k = mu[1024 + ch], mu_v = mu[2048 + ch];
    const float w0 = in[8][l * RW + ch], a0 = in[10][l * RW + ch], kkc = in[12][l * RW + ch], kac = in[13][l * RW + ch], rkc = in[14][l * RW + ch];
    const float lnw = in[15][l * RW + ch], lnb = in[16][l * RW + ch];
    for (int i = tid; i < ASZ / 4; i += 512) { ((LAS unsigned*)ST)[i] = 0u; ((LAS unsigned*)TT)[i] = 0u; ((LAS unsigned*)TTt)[i] = 0u; }
    f32x16 X;
#pragma unroll
    for (int i = 0; i < 16; ++i) X[i] = 0.f;
    const size_t mbase = (size_t)b * T;
    unsigned pr[9], pk[9], pv[9], pwl[8], pal[8], pgl[8];
#define LDW(ptr) (*(const unsigned*)((ptr) + (lnx & ~1)))
#define bf2f_lo(u) __uint_as_float(((u) >> sh16) << 16)
    auto load_raw = [&](int c, int lnx) {
        const size_t m0 = mbase + (size_t)c * 64 + 8 * wave;
        const bf16* p = proj + m0 * PW + hh * 64; const bf16* q = lr + m0 * LRN + hh * 64;
        if (c == 0 && wave == 0) { pr[0] = 0; pk[0] = 0; pv[0] = 0; } else { const bf16* pm = p - PW; pr[0] = LDW(pm); pk[0] = LDW(pm + 1024); pv[0] = LDW(pm + 2048); }
#pragma unroll
        for (int j = 0; j < 8; ++j) { const bf16* pj = p + (size_t)j * PW; const bf16* qj = q + (size_t)j * LRN;
            pr[j + 1] = LDW(pj); pk[j + 1] = LDW(pj + 1024); pv[j + 1] = LDW(pj + 2048);
            pwl[j] = LDW(qj); pal[j] = LDW(qj + 1024); pgl[j] = LDW(qj + 2048); }
    };
    load_raw(0, lane);
    __syncthreads();
    for (int c = 0; c < T / 64; ++c) {
        if (c == SEG_C1 || c == SEG_C2 || c == SEG_C3) grid_sync(gb);
        int ln = lane; asm volatile("" : "+v"(ln));
        const int r = ln & 31, h = ln >> 5;
        const int sh16 = (ln & 1) * 16;
        const int lf = r * LD + 16 * h, lm = (4 * h * LDF + r) * 4, lmt = (r * LDF + 4 * h) * 4, lt = r * LD + 8 * h, lp = 2 * ln, lq = ln * LD;
#define FR(arr, tile, ks) (*(const LAS bf16x8*)((arr) + (32 * (tile)) * LD + 32 * (ks) + lf))
        float vj[8], gj[8], bj[8];
        LAS float* rscr = (LAS float*)(lds + O_B) + wave * 528;
        {
            float rj[8], kmj[8], kkj[8], aj[8], cg[8];
            float run = 0.f;
            float pn[8], pb[8];
#pragma unroll
            for (int j = 0; j < 8; ++j) {
                const float rc = bf2f_lo(pr[j + 1]), kc = bf2f_lo(pk[j + 1]), vc = bf2f_lo(pv[j + 1]);
                const float rr = rc + (bf2f_lo(pr[j]) - rc) * mu_r, kx = kc + (bf2f_lo(pk[j]) - kc) * mu_k, vv = vc + (bf2f_lo(pv[j]) - vc) * mu_v;
                const float lw = -0.6065306597f * sigm(w0 + bf2f_lo(pwl[j]));
                const float a = sigm(a0 + bf2f_lo(pal[j]));
                const float kk = kx * kkc, km = kx * (1.0f + (a - 1.0f) * kac);
                pn[j] = kk * kk; pb[j] = rr * km * rkc;
                run += lw; cg[j] = run;
                rj[j] = rr; kmj[j] = km; kkj[j] = kk; aj[j] = a; vj[j] = vv; gj[j] = bf2f_lo(pgl[j]);
            }
            float nt[8];
            wave_sum8(rscr, ln, pn, nt); wave_sum8(rscr, ln, pb, bj);
#pragma unroll
            for (int j = 0; j < 8; ++j) kkj[j] *= fminf(__builtin_amdgcn_rsqf(nt[j]), 1e12f);
            Pw[wave * 64 + ln] = run;
            LBAR();
            float pre = 0.f, tot = 0.f;
#pragma unroll
            for (int w2 = 0; w2 < 8; ++w2) { const float pw2 = Pw[w2 * 64 + ln]; tot += pw2; if (w2 < wave) pre += pw2; }
            unsigned btp[4], ktp[4], vtp[4];
            float eprev = __expf(pre);
#pragma unroll
            for (int j = 0; j < 8; j += 2) {
                float bt2[2], kt2[2];
#pragma unroll
                for (int e = 0; e < 2; ++e) {
                    const int t = 8 * wave + j + e;
                    const float eG = __expf(pre + cg[j + e]), enG = __builtin_amdgcn_rcpf(eG);
                    bt2[e] = kkj[j + e] * aj[j + e] * enG; kt2[e] = kmj[j + e] * enG;
                    *(LAS bf16*)(A_ + t * LD + lp) = (bf16)f2bf(-kkj[j + e] * eprev);
                    *(LAS bf16*)(B_ + t * LD + lp) = (bf16)f2bf(bt2[e]);
                    *(LAS bf16*)(K_ + t * LD + lp) = (bf16)f2bf(kt2[e]);
                    *(LAS bf16*)(R_ + t * LD + lp) = (bf16)f2bf(rj[j + e] * eG);
                    eprev = eG;
                }
                btp[j >> 1] = pk2(bt2[0], bt2[1]); ktp[j >> 1] = pk2(kt2[0], kt2[1]); vtp[j >> 1] = pk2(vj[j], vj[j + 1]);
            }
            *(LAS v4u*)(BT + lq + 16 * wave) = (v4u){btp[0], btp[1], btp[2], btp[3]};
            *(LAS v4u*)(KT + lq + 16 * wave) = (v4u){ktp[0], ktp[1], ktp[2], ktp[3]};
            *(LAS v4u*)(VT + lq + 16 * wave) = (v4u){vtp[0], vtp[1], vtp[2], vtp[3]};
            if (wave == 0) GLs[ln] = __expf(tot);
        }
        LBAR();
        if (c + 1 < T / 64) load_raw(c + 1, ln);
        {
            const int p = wave >> 1, ti = wave & 1;
            const LAS unsigned char* Aop = (p < 2) ? A_ : R_; const LAS unsigned char* Bop = (p & 1) ? K_ : B_;
            const int t = 32 * ti + r, incl = (p >= 2) ? 1 : 0;
            LAS unsigned char* dst = (p == 1) ? MK : (p == 2) ? NB : NK;
#pragma unroll
            for (int si = 0; si < 2; ++si) {
                f32x16 acc;
#pragma unroll
                for (int i = 0; i < 16; ++i) acc[i] = 0.f;
                if (!(ti == 0 && si == 1)) {
#pragma unroll
                    for (int ks = 0; ks < 4; ++ks) acc = MFMA32(FR(Bop, si, ks), FR(Aop, ti, ks), acc);
                }
#pragma unroll
                for (int g = 0; g < 4; ++g) {
                    const int s0 = 32 * si + 8 * g + 4 * h;
                    const float m0 = (s0 < t + incl) ? acc[4 * g] : 0.f, m1 = (s0 + 1 < t + incl) ? acc[4 * g + 1] : 0.f, m2 = (s0 + 2 < t + incl) ? acc[4 * g + 2] : 0.f, m3 = (s0 + 3 < t + incl) ? acc[4 * g + 3] : 0.f;
                    if (p == 0) *(LAS f32x4*)((LAS unsigned char*)MF + ((32 * ti) * LDF + 32 * si + 8 * g) * 4 + lmt) = (f32x4){m0, m1, m2, m3};
                    else *(LAS v2u*)(dst + (32 * ti) * LD + 64 * si + 16 * g + lt) = (v2u){pk2(m0, m1), pk2(m2, m3)};
                }
            }
        }
        LBAR();
        const int ti4 = (wave >> 1) & 1, vi4 = wave & 1;
        if (wave < 4) {
            f32x16 acc;
#pragma unroll
            for (int i = 0; i < 16; ++i) acc[i] = 0.f;
#pragma unroll
            for (int ks = 0; ks < 4; ++ks) acc = MFMA32(FR(MK, ti4, ks), FR(VT, vi4, ks), acc);
#pragma unroll
            for (int ks = 0; ks < 4; ++ks) acc = MFMA32(FR(A_, ti4, ks), FR(ST, vi4, ks), acc);
#pragma unroll
            for (int g = 0; g < 4; ++g)
                *(LAS v2u*)(WT + (32 * vi4) * LD + 64 * ti4 + 16 * g + lt) = (v2u){pk2(acc[4 * g], acc[4 * g + 1]), pk2(acc[4 * g + 2], acc[4 * g + 3])};
        } else if (wave == 4) {
            const int l15 = ln & 15, g4 = ln >> 4;
            float x[16];
#pragma unroll
            for (int i = 0; i < 16; ++i) x[i] = 0.f;
#pragma unroll
            for (int i = 0; i < 16; ++i) {
                float s = (i == l15) ? 1.0f : 0.0f;
#pragma unroll
                for (int mq = 0; mq < (i + 3) / 4; ++mq) {
                    const f32x4 m4 = *(const LAS f32x4*)(MF + (16 * g4 + i) * LDF + 16 * g4 + 4 * mq);
                    s += m4[0] * x[4 * mq] + m4[1] * x[4 * mq + 1] + m4[2] * x[4 * mq + 2] + m4[3] * x[4 * mq + 3];
                }
                if ((i & 3) == 3) asm volatile("" : "+v"(s) :: "memory");
                x[i] = s;
            }
#pragma unroll
            for (int i = 0; i < 16; ++i) *(LAS bf16*)(TT + (16 * g4 + i) * LD + 2 * (16 * g4 + l15)) = (bf16)f2bf(x[i]);
            *(LAS v4u*)(TTt + (16 * g4 + l15) * LD + 2 * (16 * g4)) = (v4u){pk2(x[0], x[1]), pk2(x[2], x[3]), pk2(x[4], x[5]), pk2(x[6], x[7])};
            *(LAS v4u*)(TTt + (16 * g4 + l15) * LD + 2 * (16 * g4) + 16) = (v4u){pk2(x[8], x[9]), pk2(x[10], x[11]), pk2(x[12], x[13]), pk2(x[14], x[15])};
        }
        auto merge = [&](int bi, int bjj) {
            const int l15 = ln & 15, g4 = ln >> 4, d = bi - bjj;
            LAS unsigned char* Ptw = Pt + 768 * (wave - 5);
            f32x4 P = {0.f, 0.f, 0.f, 0.f};
            const bf16x8 zf = {0, 0, 0, 0, 0, 0, 0, 0};
#pragma unroll
            for (int ks = 0; ks < 2; ++ks) {
                if (32 * ks < 16 * d) {
                    const int kq = 32 * ks + 8 * g4;
                    bf16x8 af = zf, bfr = zf;
                    if (kq < 16 * d) {
                        const f32x4 m0 = *(const LAS f32x4*)(MF + (16 * bi + l15) * LDF + 16 * bjj + kq), m1 = *(const LAS f32x4*)(MF + (16 * bi + l15) * LDF + 16 * bjj + kq + 4);
                        const v4u pa = (v4u){pk2(m0[0], m0[1]), pk2(m0[2], m0[3]), pk2(m1[0], m1[1]), pk2(m1[2], m1[3])};
                        af = __builtin_bit_cast(bf16x8, pa);
                        bfr = *(const LAS bf16x8*)(TTt + (16 * bjj + l15) * LD + 2 * (16 * bjj + kq));
                    }
                    P = MFMA16(af, bfr, P);
                }
            }
            *(LAS v2u*)(Ptw + l15 * 48 + 8 * g4) = (v2u){pk2(P[0], P[1]), pk2(P[2], P[3])};
            LDS_WAIT(); asm volatile("" ::: "memory");
            bf16x8 a2 = zf, b2 = zf;
            if (g4 < 2) { a2 = *(const LAS bf16x8*)(TT + (16 * bi + l15) * LD + 2 * (16 * bi + 8 * g4)); b2 = *(const LAS bf16x8*)(Ptw + l15 * 48 + 16 * g4); }
            const f32x4 zero4 = {0.f, 0.f, 0.f, 0.f}; const f32x4 Tij = MFMA16(a2, b2, zero4);
#pragma unroll
            for (int e = 0; e < 4; ++e) *(LAS bf16*)(TT + (16 * bi + 4 * g4 + e) * LD + 2 * (16 * bjj + l15)) = (bf16)f2bf(Tij[e]);
            *(LAS v2u*)(TTt + (16 * bjj + l15) * LD + 2 * (16 * bi + 4 * g4)) = (v2u){pk2(Tij[0], Tij[1]), pk2(Tij[2], Tij[3])};
        };
        LBAR();
        if (wave >= 5) merge(wave - 4, wave - 5);
        LBAR();
        if (wave == 5 || wave == 6) merge(wave - 3, wave - 5);
        LBAR();
        if (wave == 5) merge(3, 0);
        LBAR();
        if (wave < 4) {
            f32x16 acc;
#pragma unroll
            for (int i = 0; i < 16; ++i) acc[i] = 0.f;
#pragma unroll
            for (int ks = 0; ks < 4; ++ks) if (ks < 2 * (ti4 + 1)) acc = MFMA32(FR(TT, ti4, ks), FR(WT, vi4, ks), acc);
#pragma unroll
            for (int g = 0; g < 4; ++g)
                *(LAS v2u*)(UT + (32 * vi4) * LD + 64 * ti4 + 16 * g + lt) = (v2u){pk2(acc[4 * g], acc[4 * g + 1]), pk2(acc[4 * g + 2], acc[4 * g + 3])};
        }
        LBAR();
        if (wave < 4) {
            f32x16 acc;
#pragma unroll
            for (int i = 0; i < 16; ++i) acc[i] = 0.f;
#pragma unroll
            for (int ks = 0; ks < 4; ++ks) acc = MFMA32(FR(R_, ti4, ks), FR(ST, vi4, ks), acc);
#pragma unroll
            for (int ks = 0; ks < 4; ++ks) if (ks < 2 * (ti4 + 1)) acc = MFMA32(FR(NB, ti4, ks), FR(UT, vi4, ks), acc);
#pragma unroll
            for (int ks = 0; ks < 4; ++ks) if (ks < 2 * (ti4 + 1)) acc = MFMA32(FR(NK, ti4, ks), FR(VT, vi4, ks), acc);
#pragma unroll
            for (int i = 0; i < 16; ++i) *(LAS float*)((LAS unsigned char*)MF + ((32 * ti4 + (i & 3) + 8 * (i >> 2)) * LDF + 32 * vi4) * 4 + lm) = acc[i];
        } else {
#pragma unroll
            for (int ks = 0; ks < 4; ++ks) X = MFMA32(FR(BT, ti4, ks), FR(UT, vi4, ks), X);
#pragma unroll
            for (int ks = 0; ks < 4; ++ks) X = MFMA32(FR(KT, ti4, ks), FR(VT, vi4, ks), X);
#pragma unroll
            for (int g = 0; g < 4; ++g) { const f32x4 e = *(const LAS f32x4*)(GLs + 32 * ti4 + 8 * g + 4 * h);
#pragma unroll
                for (int q = 0; q < 4; ++q) X[4 * g + q] *= e[q]; }
        }
        LBAR();
        if (wave >= 4) {
#pragma unroll
            for (int g = 0; g < 4; ++g)
                *(LAS v2u*)(ST + (32 * vi4) * LD + 64 * ti4 + 16 * g + lt) = (v2u){pk2(X[4 * g], X[4 * g + 1]), pk2(X[4 * g + 2], X[4 * g + 3])};
        }
        {
            float ov[8], o2[8], s1[8], s2[8];
#pragma unroll
            for (int j = 0; j < 8; ++j) { ov[j] = MF[(8 * wave + j) * LDF + ln]; o2[j] = ov[j] * ov[j]; }
            wave_sum8(rscr, ln, ov, s1); wave_sum8(rscr, ln, o2, s2);
            bf16* yrow = y + (mbase + (size_t)c * 64 + 8 * wave) * D + hh * 64;
#pragma unroll
            for (int j = 0; j < 8; ++j) {
                const float mean = s1[j] * (1.0f / 64.0f), var = fmaxf(s2[j] * (1.0f / 64.0f) - mean * mean, 0.f);
                const float on = (ov[j] - mean) * __builtin_amdgcn_rsqf(var + 64e-5f) * lnw + lnb;
                (yrow + (size_t)j * D)[ln] = (bf16)f2bf((on + bj[j] * vj[j]) * gj[j]);
            }
        }
#undef FR
    }
    __syncthreads();
#undef LDW
#undef bf2f_lo
}

__device__ __forceinline__ void lowrank_tile(LAS unsigned char* lds, PTab in, int l, const bf16* proj, const bf16* wlr, bf16* lr, int tile, int tid) {
    constexpr int LDA = 528, LDS_ST = 144;
    const int lane = tid & 63, wave = __builtin_amdgcn_readfirstlane(tid >> 6), r = lane & 31, h = lane >> 5;
    LAS unsigned char* At = lds; LAS unsigned char* stg = lds + 128 * LDA + wave * (32 * LDS_ST);
    const int m0 = tile * 128;
    {
        const f32x4 mu4 = *(const f32x4*)(in[6] + l * 3328 + P_LR + 4 * lane);
        const int rbase = 16 * wave;
        const bf16* pr = proj + (size_t)(m0 + rbase) * PW + P_LR + 4 * lane;
        v2u pu = (v2u){0u, 0u}; if (((m0 + rbase) & (T - 1)) != 0) pu = *(const v2u*)(pr - PW);
#pragma unroll 4
        for (int i = 0; i < 16; ++i) {
            const v2u cu = *(const v2u*)(pr + (size_t)i * PW);
            float xv[4] = {bflo(cu.x), bfhi(cu.x), bflo(cu.y), bfhi(cu.y)}; const float pv[4] = {bflo(pu.x), bfhi(pu.x), bflo(pu.y), bfhi(pu.y)};
#pragma unroll
            for (int j = 0; j < 4; ++j) { float xx = xv[j] + (pv[j] - xv[j]) * mu4[j];
                if (lane < 16) xx = 1.0f - 2.0f * __builtin_amdgcn_rcpf(1.0f + __expf(2.0f * xx)); else if (lane >= 32) xx = sigm(xx); xv[j] = xx; }
            *(LAS v2u*)(At + (rbase + i) * LDA + 8 * lane) = (v2u){pk2(xv[0], xv[1]), pk2(xv[2], xv[3])};
            pu = cu;
        }
    }
    __syncthreads();
#pragma unroll
    for (int q = 0; q < 6; ++q) {
        constexpr int dummy = 0; (void)dummy;
        const int grp = (q < 2) ? 0 : (q < 4) ? 1 : 2, kbase = (grp == 0) ? 0 : (grp == 1) ? 64 : 128, nks = (grp == 2) ? 8 : 4;
        const int n0 = 64 * (wave + 8 * q);
        bf16x8 wf[2][8];
#pragma unroll
        for (int t2 = 0; t2 < 2; ++t2)
#pragma unroll
            for (int ks = 0; ks < 8; ++ks) if (ks < nks) wf[t2][ks] = *(const bf16x8*)(wlr + (size_t)(n0 + 32 * t2 + r) * LRK + kbase + 16 * ks + 8 * h);
#pragma unroll 1
        for (int tt = 0; tt < 4; ++tt) {
            f32x16 a0, a1;
#pragma unroll
            for (int i = 0; i < 16; ++i) { a0[i] = 0.f; a1[i] = 0.f; }
#pragma unroll
            for (int ks = 0; ks < 8; ++ks) if (ks < nks) {
                const bf16x8 af = *(const LAS bf16x8*)(At + (32 * tt + r) * LDA + (kbase + 16 * ks + 8 * h) * 2);
                a0 = MFMA32(wf[0][ks], af, a0); a1 = MFMA32(wf[1][ks], af, a1);
            }
#pragma unroll
            for (int g = 0; g < 4; ++g) {
                *(LAS v2u*)(stg + r * LDS_ST + 16 * g + 8 * h) = (v2u){pk2(a0[4 * g], a0[4 * g + 1]), pk2(a0[4 * g + 2], a0[4 * g + 3])};
                *(LAS v2u*)(stg + r * LDS_ST + 64 + 16 * g + 8 * h) = (v2u){pk2(a1[4 * g], a1[4 * g + 1]), pk2(a1[4 * g + 2], a1[4 * g + 3])};
            }
            asm volatile("" ::: "memory");
#pragma unroll
            for (int it = 0; it < 4; ++it) {
                const int row = it * 8 + (lane >> 3);
                const v4u v = *(const LAS v4u*)(stg + row * LDS_ST + 16 * (lane & 7));
                *(v4u*)(lr + (size_t)(m0 + 32 * tt + row) * LRN + n0 + 8 * (lane & 7)) = v;
            }
            asm volatile("" ::: "memory");
        }
    }
    __syncthreads();
}

__device__ __forceinline__ void cvt_item(const float* W, int K, int N, const float* gain, bf16* WT, bool gu, LAS float* scr, int item, int lane) {
    const int nblk = N / 32, kb = item / nblk, nb = item - kb * nblk, k0 = 64 * kb, n0 = 32 * nb;
    float wv[32];
    const float* wp = W + (size_t)(k0 + (lane >> 5)) * N + n0 + (lane & 31);
#pragma unroll
    for (int i = 0; i < 32; ++i) wv[i] = wp[(size_t)(2 * i) * N];
#pragma unroll
    for (int i = 0; i < 32; ++i) { const int kk = 2 * i + (lane >> 5); const float g = gain ? gain[k0 + kk] : 1.0f; scr[kk * 33 + (lane & 31)] = wv[i] * g; }
    LDS_WAIT(); asm volatile("" ::: "memory");
    int r0 = n0;
    if (gu) { if (n0 < FF) r0 = 256 * (n0 / 128) + (n0 % 128); else { const int n1 = n0 - FF; r0 = 256 * (n1 / 128) + 128 + (n1 % 128); } }
    const int c = lane & 7;
#pragma unroll
    for (int j = 0; j < 4; ++j) { const int n = (lane >> 3) + 8 * j; const LAS float* s = scr + (8 * c) * 33 + n;
        v4u o; o.x = pk2(s[0 * 33], s[1 * 33]); o.y = pk2(s[2 * 33], s[3 * 33]); o.z = pk2(s[4 * 33], s[5 * 33]); o.w = pk2(s[6 * 33], s[7 * 33]);
        *(v4u*)(WT + (size_t)(r0 + n) * K + k0 + 8 * c) = o; }
    LDS_WAIT(); asm volatile("" ::: "memory");
}

__device__ __forceinline__ void rwkv_chain(LAS unsigned char* lds, PTab in, int l, int b, int h, const bf16* proj, const bf16* lr, bf16* y, int lane, int wave) {
    constexpr int TC = 32;
    LAS float* sR = (LAS float*)lds; LAS float* sW = sR + TC * 64; LAS float* sK = sW + TC * 64; LAS float* sV = sK + TC * 64;
    LAS float* sA = sV + TC * 64; LAS float* sB = sA + TC * 64; LAS float* sO = sB + TC * 64; LAS float* sBon = sO + TC * 64;
    const int ch = h * 64 + lane;
    const float* mu = in[6] + l * 3328;
    const float mu_r = mu[ch], mu_k = mu[1024 + ch], mu_v = mu[2048 + ch];
    const float w0 = in[8][l * RW + ch], a0 = in[10][l * RW + ch], kkc = in[12][l * RW + ch], kac = in[13][l * RW + ch], rkc = in[14][l * RW + ch];
    const float lnw = in[15][l * RW + ch], lnb = in[16][l * RW + ch];
    float S[8];
#pragma unroll
    for (int j = 0; j < 8; ++j) S[j] = 0.f;
    const int rowl = lane >> 3, kp = lane & 7;
    for (int c = 0; c < T / TC; ++c) {
#pragma unroll
        for (int i = 0; i < TC / 8; ++i) {
            const int tt = wave * (TC / 8) + i, t = c * TC + tt; const size_t m = (size_t)b * T + t;
            const bf16* pr = proj + m * PW; const bf16* lq = lr + m * LRN;
            const float rc = bf2f(pr[ch]), kc = bf2f(pr[1024 + ch]), vc = bf2f(pr[2048 + ch]);
            float rp = 0.f, kq0 = 0.f, vp = 0.f;
            if (t > 0) { const bf16* pp = pr - PW; rp = bf2f(pp[ch]); kq0 = bf2f(pp[1024 + ch]); vp = bf2f(pp[2048 + ch]); }
            const float r = rc + (rp - rc) * mu_r, k = kc + (kq0 - kc) * mu_k, v = vc + (vp - vc) * mu_v;
            const float wl = bf2f(lq[ch]), al = bf2f(lq[1024 + ch]);
            const float decay = __expf(-0.6065306597f * sigm(w0 + wl));
            const float a = sigm(a0 + al);
            float kk = k * kkc; const float nrm = sqrtf(wave_sum(kk * kk)); kk = kk / fmaxf(nrm, 1e-12f);
            const float kq = k * (1.0f + (a - 1.0f) * kac);
            const float bon = wave_sum(r * kq * rkc);
            sR[tt * 64 + lane] = r; sW[tt * 64 + lane] = decay; sK[tt * 64 + lane] = kq; sV[tt * 64 + lane] = v; sA[tt * 64 + lane] = -kk; sB[tt * 64 + lane] = kk * a;
            if (lane == 0) sBon[tt] = bon;
        }
        __syncthreads();
#pragma unroll 2
        for (int tt = 0; tt < TC; ++tt) {
            const int o8 = tt * 64 + kp * 8;
            const f32x4 a0v = *(const LAS f32x4*)(sA + o8), a1v = *(const LAS f32x4*)(sA + o8 + 4);
            const f32x4 w0v = *(const LAS f32x4*)(sW + o8), w1v = *(const LAS f32x4*)(sW + o8 + 4);
            const f32x4 b0v = *(const LAS f32x4*)(sB + o8), b1v = *(const LAS f32x4*)(sB + o8 + 4);
            const f32x4 k0v = *(const LAS f32x4*)(sK + o8), k1v = *(const LAS f32x4*)(sK + o8 + 4);
            const f32x4 r0v = *(const LAS f32x4*)(sR + o8), r1v = *(const LAS f32x4*)(sR + o8 + 4);
            const float vv = sV[tt * 64 + wave * 8 + rowl];
            float sa = 0.f;
#pragma unroll
            for (int j = 0; j < 4; ++j) { sa = fmaf(S[j], a0v[j], sa); sa = fmaf(S[4 + j], a1v[j], sa); }
            sa = sum8(sa);
#pragma unroll
            for (int j = 0; j < 4; ++j) {
                S[j] = fmaf(S[j], w0v[j], fmaf(sa, b0v[j], vv * k0v[j]));
                S[4 + j] = fmaf(S[4 + j], w1v[j], fmaf(sa, b1v[j], vv * k1v[j]));
            }
            float o = 0.f;
#pragma unroll
            for (int j = 0; j < 4; ++j) { o = fmaf(S[j], r0v[j], o); o = fmaf(S[4 + j], r1v[j], o); }
            o = sum8(o);
            if (kp == 0) sO[tt * 64 + wave * 8 + rowl] = o;
        }
        __syncthreads();
#pragma unroll
        for (int i = 0; i < TC / 8; ++i) {
            const int tt = wave * (TC / 8) + i, t = c * TC + tt; const size_t m = (size_t)b * T + t;
            const float o = sO[tt * 64 + lane];
            const float mean = wave_sum(o) * (1.0f / 64.0f); const float d = o - mean;
            const float var = wave_sum(d * d) * (1.0f / 64.0f);
            const float on = d * rsqrtf(var + 64e-5f) * lnw + lnb;
            const float g = bf2f(lr[m * LRN + 2048 + ch]);
            const float yv = (on + sBon[tt] * sV[tt * 64 + lane]) * g;
            y[m * D + ch] = (bf16)f2bf(yv);
        }
        __syncthreads();
    }
}
__device__ __forceinline__ void hgrn_chain(LAS unsigned char* lds, PTab in, int l, int b, int h, const bf16* proj, bf16* y, int lane, int wave) {
    constexpr int TC = 16;
    LAS float* sQ = (LAS float*)lds; LAS float* sF = sQ + TC * 128; LAS float* sKK = sF + TC * 128; LAS float* sI = sKK + TC * 128; LAS float* sOP = sI + TC * 128;
    float lb[2], nw[2];
#pragma unroll
    for (int e = 0; e < 2; ++e) {
        const int cc = h * 128 + lane + 64 * e;
        const float* hlb = in[18]; const float x0 = hlb[cc], x1 = hlb[512 + cc], x2 = hlb[1024 + cc], x3 = hlb[1536 + cc];
        const float mx = fmaxf(fmaxf(x0, x1), fmaxf(x2, x3));
        const float e0 = expf(x0 - mx), e1 = expf(x1 - mx), e2 = expf(x2 - mx), e3 = expf(x3 - mx);
        const float inv = 1.0f / (e0 + e1 + e2 + e3);
        float acc = 0.f; if (l >= 1) acc += e1; if (l >= 2) acc += e2; if (l >= 3) acc += e3;
        lb[e] = acc * inv;
        nw[e] = in[19][l * 512 + cc];
    }
    float S0[16], S1[16];
#pragma unroll
    for (int j = 0; j < 16; ++j) { S0[j] = 0.f; S1[j] = 0.f; }
    for (int c = 0; c < T / TC; ++c) {
#pragma unroll
        for (int i = 0; i < TC / 8; ++i) {
            const int tt = wave * (TC / 8) + i, t = c * TC + tt; const size_t m = (size_t)b * T + t;
            const bf16* pr = proj + m * PW + P_HG + h * 128;
#pragma unroll
            for (int e = 0; e < 2; ++e) {
                const int cc = lane + 64 * e;
                const float qr = bf2f(pr[cc]), fr = bf2f(pr[512 + cc]), iv = bf2f(pr[1024 + cc]);
                const float sg = sigm(fr);
                sQ[tt * 128 + cc] = qr * sigm(qr);
                sF[tt * 128 + cc] = fmaxf(lb[e] + (1.0f - lb[e]) * sg, 1e-30f);
                sKK[tt * 128 + cc] = (1.0f - lb[e]) * (1.0f - sg);
                sI[tt * 128 + cc] = iv;
            }
        }
        __syncthreads();
#pragma unroll 2
        for (int tt = 0; tt < TC; ++tt) {
            const int o16 = tt * 128 + wave * 16;
            f32x4 f4[4], k4[4], q4[4];
#pragma unroll
            for (int u = 0; u < 4; ++u) { f4[u] = *(const LAS f32x4*)(sF + o16 + 4 * u); k4[u] = *(const LAS f32x4*)(sKK + o16 + 4 * u); q4[u] = *(const LAS f32x4*)(sQ + o16 + 4 * u); }
            const float i0 = sI[tt * 128 + lane], i1 = sI[tt * 128 + 64 + lane];
            float o0 = 0.f, o1 = 0.f;
#pragma unroll
            for (int u = 0; u < 4; ++u)
#pragma unroll
                for (int j = 0; j < 4; ++j) {
                    S0[4 * u + j] = fmaf(f4[u][j], S0[4 * u + j], k4[u][j] * i0);
                    S1[4 * u + j] = fmaf(f4[u][j], S1[4 * u + j], k4[u][j] * i1);
                    o0 = fmaf(q4[u][j], S0[4 * u + j], o0); o1 = fmaf(q4[u][j], S1[4 * u + j], o1);
                }
            sOP[(tt * 8 + wave) * 128 + lane] = o0; sOP[(tt * 8 + wave) * 128 + 64 + lane] = o1;
        }
        __syncthreads();
#pragma unroll
        for (int i = 0; i < TC / 8; ++i) {
            const int tt = wave * (TC / 8) + i, t = c * TC + tt; const size_t m = (size_t)b * T + t;
            float o0 = 0.f, o1 = 0.f;
#pragma unroll
            for (int w = 0; w < 8; ++w) { o0 += sOP[(tt * 8 + w) * 128 + lane]; o1 += sOP[(tt * 8 + w) * 128 + 64 + lane]; }
            const float ms = wave_sum(o0 * o0 + o1 * o1) * (1.0f / 128.0f);
            const float rs = rsqrtf(ms + 1e-5f);
            const bf16* pg = proj + m * PW + P_HG + 1536 + h * 128;
            const float g0 = bf2f(pg[lane]), g1 = bf2f(pg[64 + lane]);
            bf16* yo = y + m * D + Y_HG + h * 128;
            yo[lane] = (bf16)f2bf(o0 * rs * nw[0] * (g0 * sigm(g0)));
            yo[64 + lane] = (bf16)f2bf(o1 * rs * nw[1] * (g1 * sigm(g1)));
        }
        __syncthreads();
    }
}
__device__ __forceinline__ void conv_rows(PTab in, int l, const bf16* proj, bf16* y, int slice, int nslices, int lane, int wave) {
    const float* cw = in[17] + l * 3 * 512;
    float w0[8], w1[8], w2[8];
#pragma unroll
    for (int j = 0; j < 8; ++j) { w0[j] = cw[8 * lane + j]; w1[j] = cw[512 + 8 * lane + j]; w2[j] = cw[1024 + 8 * lane + j]; }
    for (int m = slice * NWAVES + wave; m < M; m += nslices * NWAVES) {
        const int t = m & (T - 1);
        const bf16* pr = proj + (size_t)m * PW + P_CONV + 8 * lane;
        const v4u c2 = *(const v4u*)pr, x2 = *(const v4u*)(pr + 512), bg = *(const v4u*)(pr + 1024);
        v4u c1 = (v4u){0u, 0u, 0u, 0u}, x1 = c1, c0 = c1, x0 = c1;
        if (t >= 1) { c1 = *(const v4u*)(pr - PW); x1 = *(const v4u*)(pr - PW + 512); }
        if (t >= 2) { c0 = *(const v4u*)(pr - 2 * PW); x0 = *(const v4u*)(pr - 2 * PW + 512); }
        v4u o;
#pragma unroll
        for (int q = 0; q < 4; ++q) {
            const float lo = bflo(bg[q]) * (bflo(c2[q]) * bflo(x2[q]) * w2[2 * q] + bflo(c1[q]) * bflo(x1[q]) * w1[2 * q] + bflo(c0[q]) * bflo(x0[q]) * w0[2 * q]);
            const float hi = bfhi(bg[q]) * (bfhi(c2[q]) * bfhi(x2[q]) * w2[2 * q + 1] + bfhi(c1[q]) * bfhi(x1[q]) * w1[2 * q + 1] + bfhi(c0[q]) * bfhi(x0[q]) * w0[2 * q + 1]);
            o[q] = pk2(lo, hi);
        }
        *(v4u*)(y + (size_t)m * D + Y_CONV + 8 * lane) = o;
    }
}


__device__ __forceinline__ void cvt_groups(PTab in, unsigned char* ws, LAS float* scr, int la, int lb, int w0, int nw, int lane) {
    constexpr int I_GU = (D / 64) * (2 * FF / 32), I_DN = (FF / 64) * (D / 32), I_IN = (D / 64) * (PW / 32), I_O = (D / 64) * (D / 32);
    if (lb >= 0) {
        for (int it = w0; it < I_O + I_GU + I_DN; it += nw) {
            int r = it;
            if (r < I_O) { cvt_item(in[20] + (size_t)lb * D * D, D, D, nullptr, (bf16*)(ws + W_OUT), false, scr, r, lane); continue; } r -= I_O;
            if (r < I_GU) { cvt_item(in[22] + (size_t)lb * D * 2 * FF, D, 2 * FF, in[21] + lb * D, (bf16*)(ws + W_GU2), true, scr, r, lane); continue; } r -= I_GU;
            cvt_item(in[23] + (size_t)lb * FF * D, FF, D, nullptr, (bf16*)(ws + W_D2), false, scr, r, lane);
        }
    }
    if (la >= 0) {
        for (int it = w0; it < I_GU + I_DN + I_IN; it += nw) {
            int r = it;
            if (r < I_GU) { cvt_item(in[2] + (size_t)la * D * 2 * FF, D, 2 * FF, in[1] + la * D, (bf16*)(ws + W_GU1), true, scr, r, lane); continue; } r -= I_GU;
            if (r < I_DN) { cvt_item(in[3] + (size_t)la * FF * D, FF, D, nullptr, (bf16*)(ws + W_D1), false, scr, r, lane); continue; } r -= I_DN;
            cvt_item(in[5] + (size_t)la * D * PW, D, PW, in[4] + la * D, (bf16*)(ws + W_IN), false, scr, r, lane);
        }
        bf16* wl = (bf16*)(ws + W_LR);
        const float* wup = in[7] + (size_t)la * 64 * RW; const float* aup = in[9] + (size_t)la * 64 * RW; const float* gup = in[11] + (size_t)la * 128 * RW;
        for (int idx = w0 * 64 + lane; idx < LRN * LRK; idx += nw * 64) {
            const int n = idx >> 8, k = idx & 255; float v = 0.f;
            if (n < 1024) { if (k < 64) v = wup[k * RW + n]; }
            else if (n < 2048) { if (k >= 64 && k < 128) v = aup[(k - 64) * RW + (n - 1024)]; }
            else { if (k >= 128) v = gup[(k - 128) * RW + (n - 2048)]; }
            wl[idx] = (bf16)f2bf(v);
        }
    }
}

struct Args { const float* in[25]; float* out; unsigned char* ws; int ph_lo, ph_hi; };
__global__ void __launch_bounds__(NWAVES * 64, 2) fwd(Args args) {
    extern __shared__ __attribute__((aligned(16))) unsigned char lds_raw[];
    LAS unsigned char* lds = (LAS unsigned char*)lds_raw;
    volatile LAS unsigned* MISC = (volatile LAS unsigned*)(lds + MISC_OFF);
    const int tid0 = threadIdx.x;
    const int wv0 = __builtin_amdgcn_readfirstlane(tid0 >> 6);
#if MK_N_LAUNCHES == 1
    constexpr int lo = 0, hi = NPH;
#else
    const int lo = args.ph_lo, hi = args.ph_hi;
#endif
    PTab in; in.t = (LAS unsigned long long*)(lds + PTAB_OFF);
    if (tid0 < 32) MISC[tid0] = 0u;
    if (tid0 == 0) {
#define PT_SET(i) in.t[i] = (unsigned long long)args.in[i]
        PT_SET(0); PT_SET(1); PT_SET(2); PT_SET(3); PT_SET(4); PT_SET(5); PT_SET(6); PT_SET(7); PT_SET(8); PT_SET(9); PT_SET(10); PT_SET(11); PT_SET(12);
        PT_SET(13); PT_SET(14); PT_SET(15); PT_SET(16); PT_SET(17); PT_SET(18); PT_SET(19); PT_SET(20); PT_SET(21); PT_SET(22); PT_SET(23); PT_SET(24);
#undef PT_SET
        in.t[25] = (unsigned long long)args.out; in.t[26] = (unsigned long long)args.ws;
    }
    __syncthreads();
    if (hi - lo > 1) (void)xcd_barrier_post((unsigned*)((unsigned char*)in[26] + WS_CTL) + CW_BAR, MISC + 8);
    int pc = 0;
#define PH_ON (pc >= lo && pc < hi)
#define PH_BEGIN int G = gridDim.x, bid = blockIdx.x, tid = wv0 * 64 + pg8::lane_id(); unsigned char* ws = (unsigned char*)in[26]; float* out = (float*)in[25]; \
    asm volatile("" : "+s"(G), "+s"(bid), "+v"(tid)); \
    const int lane = tid & 63, wave = __builtin_amdgcn_readfirstlane(tid >> 6); (void)lane; \
    const int gw = bid * NWAVES + wave, NGW = G * NWAVES; pg8::ssq_t* ssq = (pg8::ssq_t*)(ws + WS_SS); \
    bf16* HB = (bf16*)(ws + WS_HB); bf16* PROJ = (bf16*)(ws + WS_PROJ); bf16* ACT = (bf16*)(ws + WS_ACT); bf16* LRA = (bf16*)(ws + WS_LRA); bf16* LR = (bf16*)(ws + WS_LR); bf16* Y = (bf16*)(ws + WS_Y); \
    (void)gw; (void)NGW; (void)ssq; (void)HB; (void)PROJ; (void)ACT; (void)LRA; (void)LR; (void)Y; (void)out;
#define PH_END do { if (pc >= lo && pc + 1 < hi) { XcdBarrier bar_; bar_.bar = (unsigned*)((unsigned char*)in[26] + WS_CTL) + CW_BAR; bar_.x = xb_xcc_id(); bar_.st = MISC + 8; bar_.lead = (wv0 == 0) && (pg8::lane_id() == 0); xcd_barrier(bar_); } ++pc; } while (0)

    if (PH_ON) { PH_BEGIN
        const float* x = in[0];
        for (int m = gw; m < M; m += NGW) {
            const f32x4* xr = (const f32x4*)(x + (size_t)m * D) + lane; v2u* ho = (v2u*)(HB + (size_t)m * D) + lane;
            f32x4 v[8]; float s = 0.f;
#pragma unroll
            for (int j = 0; j < 8; ++j) { v[j] = xr[64 * j]; s += (v[j][0] * v[j][0] + v[j][1] * v[j][1]) + (v[j][2] * v[j][2] + v[j][3] * v[j][3]); }
#pragma unroll
            for (int j = 0; j < 8; ++j) { v2u o; o.x = pk2(v[j][0], v[j][1]); o.y = pk2(v[j][2], v[j][3]); ho[64 * j] = o; }
            s = wave_sum(s);
            if (lane == 0) ssq[m] = pg8::ssq_fix(s);
        }
        cvt_groups(in, ws, (LAS float*)(lds + wave * 16384), 0, -1, gw, NGW, lane);
    }
    PH_END;

    for (int l = 0; l < DEPTH; ++l) {
        for (int hf = 0; hf < 2; ++hf) {
            if (hf == 1) {
                if (PH_ON) { PH_BEGIN
                    pg8::Gemm g{HB, (const bf16*)(ws + W_IN), M, PW, D}; pg8::TailSplitOrder S; S.init(M, PW, G, bid);
                    pg8::EpiBf16S E{PROJ, PW, pg8::RstdCache{ssq + (size_t)(3 * l + 1) * M, (LAS float*)(lds + RING_BYTES) + wave * 128, -1}};
                    pg8::gemm_phase<pg8::EpiBf16S, pg8::TailSplitOrder, true, true>(lds, g, S, E, wave);
                }
                PH_END;
                if (PH_ON) { PH_BEGIN
                    for (int tile = bid; tile < M / 128; tile += G) { int tj = tid; asm volatile("" : "+v"(tj)); lowrank_tile(lds, in, l, PROJ, (const bf16*)(ws + W_LR), LR, tile, tj); }
                }
                PH_END;
                if (PH_ON) { PH_BEGIN
                    GBar gb; gb.bar = (unsigned*)(ws + WS_CTL) + CW_BAR; gb.st = MISC + 8; gb.wv = wave;
                    if (G == 256) {
                        const int job = bid;
                        if (job < 128) { const int tj = wave * 64 + pg8::lane_id(); rwkv_chain_mfma(lds, in, l, job >> 4, job & 15, PROJ, LR, Y, tj, gb); }
                        else if (job < 160) { const int tj = wave * 64 + pg8::lane_id(); hgrn_chain_mfma(lds, in, l, (job - 128) >> 2, (job - 128) & 3, PROJ, Y, tj, gb); }
                        else {
                            const int lj = pg8::lane_id();
                            conv_rows(in, l, PROJ, Y, job - 160, 96, lj, wave);
                            cvt_groups(in, ws, (LAS float*)(lds + wave * 16384), (l + 1 < DEPTH) ? l + 1 : -1, l, (job - 160) * NWAVES + wave, 96 * NWAVES, lj);
                            pg8::Gemm g{Y, (const bf16*)(ws + W_OUT), M, D, D};
                            pg8::EpiResid E{HB, ssq + (size_t)(3 * l + 2) * M, 1.0f};
                            for (int seg = 0; seg < 3; ++seg) {
                                grid_sync(gb);
                                const int j0 = (seg == 0) ? 0 : (seg == 1) ? SEG_J1 : SEG_J2, j1 = (seg == 0) ? SEG_J1 : (seg == 1) ? SEG_J2 : SEG_J3;
                                pg8::PanelOrder S{j0, j1 - j0, 96, (job & 7) * 12 + ((job - 160) >> 3)}; pg8::gemm_phase<pg8::EpiResid, pg8::PanelOrder, true, true>(lds, g, S, E, wave);
                            }
                        }
                        __syncthreads();
                    }
                }
                PH_END;
                if (PH_ON) { PH_BEGIN
                    pg8::Gemm g{Y, (const bf16*)(ws + W_OUT), M, D, D}; pg8::PanelOrder S{SEG_J3, 16 - SEG_J3, G, (G % 8 == 0) ? (bid & 7) * (G >> 3) + (bid >> 3) : bid};
                    pg8::EpiResid E{HB, ssq + (size_t)(3 * l + 2) * M, 1.0f};
                    pg8::gemm_phase<pg8::EpiResid, pg8::PanelOrder, true, true>(lds, g, S, E, wave);
                }
                PH_END;
            }
            if (PH_ON) { PH_BEGIN
                pg8::Gemm g{HB, (const bf16*)(ws + (hf ? W_GU2 : W_GU1)), M, 2 * FF, D}; pg8::TailSplitOrder S; S.init(M, 2 * FF, G, bid);
                pg8::EpiSwiGLU E{ACT, FF, pg8::RstdCache{ssq + (size_t)(3 * l + 2 * hf) * M, (LAS float*)(lds + RING_BYTES) + wave * 128, -1}};
                pg8::gemm_phase<pg8::EpiSwiGLU, pg8::TailSplitOrder, true, true>(lds, g, S, E, wave);
            }
            PH_END;
            if (PH_ON) { PH_BEGIN
                pg8::Gemm g{ACT, (const bf16*)(ws + (hf ? W_D2 : W_D1)), M, D, FF}; pg8::StaticOrder S; S.init(M, D, G, bid);
                pg8::EpiResid E{HB, ssq + (size_t)(3 * l + 2 * hf + 1) * M, 0.5f};
                pg8::gemm_phase<pg8::EpiResid, pg8::StaticOrder, true, true>(lds, g, S, E, wave);
            }
            PH_END;
        }
    }
    if (PH_ON) { PH_BEGIN
        const float* gn = in[24]; const pg8::ssq_t* s12 = ssq + (size_t)12 * M;
        f32x4 gv[8];
#pragma unroll
        for (int j = 0; j < 8; ++j) gv[j] = *((const f32x4*)gn + lane + 64 * j);
        for (int m = gw; m < M; m += NGW) {
            const float rs = pg8::rstd_of(s12, m);
            const v2u* hrow = (const v2u*)(HB + (size_t)m * D) + lane; f32x4* orow = (f32x4*)(out + (size_t)m * D) + lane;
#pragma unroll
            for (int j = 0; j < 8; ++j) { const v2u hv = hrow[64 * j]; const f32x4 v = {bflo(hv.x), bfhi(hv.x), bflo(hv.y), bfhi(hv.y)}; orow[64 * j] = v * rs * gv[j]; }
        }
    }
#undef PH_ON
#undef PH_END
}

extern "C" void kernel_launch(void* const* d_in, const int* in_sizes, int n_in, void* d_out, int out_size, void* d_ws, size_t ws_size, hipStream_t stream) {
    static int grid = 0;
    if (grid == 0) {
        if (n_in != 25 || in_sizes[0] != M * D || out_size != M * D || ws_size < WS_END) { fprintf(stderr, "kernel_launch: unexpected shapes (n_in %d, in0 %d, out %d, ws %zu; need ws >= %zu); nothing launched\n", n_in, n_in > 0 ? in_sizes[0] : -1, out_size, ws_size, (size_t)WS_END); grid = -1; return; }
        int dev = 0, cus = 0, per_cu = 0;
        if (hipGetDevice(&dev) != hipSuccess || hipDeviceGetAttribute(&cus, hipDeviceAttributeMultiprocessorCount, dev) != hipSuccess) { grid = -1; return; }
        if (hipFuncSetAttribute((const void*)fwd, hipFuncAttributeMaxDynamicSharedMemorySize, LDS_BYTES) != hipSuccess) { fprintf(stderr, "kernel_launch: hipFuncSetAttribute failed\n"); grid = -1; return; }
        if (hipOccupancyMaxActiveBlocksPerMultiprocessor(&per_cu, (const void*)fwd, NWAVES * 64, LDS_BYTES) != hipSuccess || per_cu < 1) { fprintf(stderr, "kernel_launch: occupancy query reports %d blocks per CU\n", per_cu); }
        (void)hipGetLastError();
        grid = cus;
    }
    if (grid < 0) return;
    if (hipMemsetAsync((char*)d_ws + WS_CTL, 0, ZERO_BYTES, stream) != hipSuccess) return;
    Args a{};
    for (int i = 0; i < 25; ++i) a.in[i] = (const float*)d_in[i];
    a.out = (float*)d_out; a.ws = (unsigned char*)d_ws;
#if MK_N_LAUNCHES == 1
    a.ph_lo = 0; a.ph_hi = NPH;
    hipLaunchKernelGGL(fwd, dim3(grid), dim3(NWAVES * 64), LDS_BYTES, stream, a);
#else
    for (int p = 0; p < NPH; ++p) { a.ph_lo = p; a.ph_hi = p + 1; hipLaunchKernelGGL(fwd, dim3(grid), dim3(NWAVES * 64), LDS_BYTES, stream, a); }
#endif
}
```
